# Optimizing an MI355X kernel written in HIP

```python
import math
import jax, jax.numpy as jnp
from jax import lax
import numpy as np

D_MODEL = 2048
BATCH = 1
SEQ = 16384
DEPTH = 1

CHUNK = 64
LEFT_CHUNKS = 8
BAND = (LEFT_CHUNKS + 1) * CHUNK
ATTN_HEADS = 8
ATTN_HEAD_DIM = 128
ATTN_WIDTH = ATTN_HEADS * ATTN_HEAD_DIM
REL_MAX = 256
REL_MIN = -(CHUNK - 1)
REL_SIZE = REL_MAX - REL_MIN + 1
RNN_WIDTH = D_MODEL // 2
RNN_BLOCKS = 8
RNN_BLOCK_W = RNN_WIDTH // RNN_BLOCKS
CONV_W = 4
RG_C = 8.0
LRU_A_MIN = 0.9
LRU_A_MAX = 0.999
SPLIT_SIZES = (ATTN_WIDTH, ATTN_WIDTH, ATTN_WIDTH, RNN_WIDTH, RNN_WIDTH, D_MODEL, D_MODEL)
IN_WIDTH = sum(SPLIT_SIZES)
SPLIT_POINTS = tuple(int(v) for v in np.cumsum(SPLIT_SIZES)[:-1])
N_EXPERTS = 32
TOP_K = 4
D_FF = D_MODEL
SWIGLU_LIMIT = 7.0
SWIGLU_ALPHA = 1.702
EXPERT_BLOCK = 256
EPS = 1e-6

kernel_name = "hybrid_chunked_attn_rglru_moe_block"


def rms_norm(x, g):
    x32 = x.astype(jnp.float32)
    y = x32 * lax.rsqrt(jnp.mean(x32 * x32, axis=-1, keepdims=True) + EPS) * g.astype(jnp.float32)
    return y.astype(x.dtype)


def chunked_band_attention(q, k, v, rel_table):
    B, S, H, Dh = q.shape
    n_chunks = S // CHUNK
    pad = LEFT_CHUNKS * CHUNK
    kp = jnp.pad(k, ((0, 0), (pad, 0), (0, 0), (0, 0)))
    vp = jnp.pad(v, ((0, 0), (pad, 0), (0, 0), (0, 0)))
    qc = q.reshape(B, n_chunks, CHUNK, H, Dh).transpose(1, 0, 2, 3, 4)
    qi = jnp.arange(CHUNK)[:, None]
    kj = jnp.arange(BAND)[None, :]
    rel_idx = jnp.clip(qi - kj + pad, REL_MIN, REL_MAX) - REL_MIN
    bias = rel_table.astype(jnp.float32)[:, rel_idx]
    scale = 1.0 / math.sqrt(Dh)

    def one_chunk(args):
        q_blk, cidx = args
        start = cidx * CHUNK
        kb = lax.dynamic_slice_in_dim(kp, start, BAND, axis=1)
        vb = lax.dynamic_slice_in_dim(vp, start, BAND, axis=1)
        s = jnp.einsum('bqhd,bkhd->bhqk', q_blk, kb).astype(jnp.float32) * scale + bias[None]
        valid = (jnp.arange(BAND) + start - pad) >= 0
        s = jnp.where(valid[None, None, None, :], s, -1e30)
        p = jax.nn.softmax(s, axis=-1).astype(vb.dtype)
        return jnp.einsum('bhqk,bkhd->bqhd', p, vb)

    out = lax.map(one_chunk, (qc, jnp.arange(n_chunks)))
    return out.transpose(1, 0, 2, 3, 4).reshape(B, S, H * Dh)


def causal_depthwise_conv(x, w, b):
    y = lax.conv_general_dilated(
        x, w[:, None, :], window_strides=(1,), padding=[(CONV_W - 1, 0)],
        dimension_numbers=('NWC', 'WIO', 'NWC'), feature_group_count=x.shape[-1])
    return y + b


def rg_lru(x, w_a, b_a, w_x, b_x, lam):
    B, S, W = x.shape
    xh = x.reshape(B, S, RNN_BLOCKS, RNN_BLOCK_W)
    r = jax.nn.sigmoid(jnp.einsum('bshi,hij->bshj', xh, w_a) + b_a).reshape(B, S, W)
    i_gate = jax.nn.sigmoid(jnp.einsum('bshi,hij->bshj', xh, w_x) + b_x).reshape(B, S, W)
    log_a = -RG_C * r.astype(jnp.float32) * jax.nn.softplus(-lam.astype(jnp.float32))
    a = jnp.exp(log_a)
    u = jnp.sqrt(-jnp.expm1(2.0 * log_a)) * (i_gate * x).astype(jnp.float32)

    def combine(left, right):
        a1, b1 = left
        a2, b2 = right
        return a1 * a2, a2 * b1 + b2

    _, h = lax.associative_scan(combine, (a, u), axis=1)
    return h.astype(x.dtype)


def moe_ffn(xn, w_router, b_router, w_gu, b_gu, w_down, b_down):
    B, S, D = xn.shape
    T = B * S
    xt = xn.reshape(T, D)
    logits = xt.astype(jnp.float32) @ w_router.astype(jnp.float32) + b_router.astype(jnp.float32)
    top_val, top_idx = lax.top_k(logits, TOP_K)
    top_w = jax.nn.softmax(top_val, axis=-1)
    e_flat = top_idx.reshape(-1).astype(jnp.int32)
    tok_flat = jnp.repeat(jnp.arange(T, dtype=jnp.int32), TOP_K)
    w_flat = top_w.reshape(-1)
    order = jnp.argsort(e_flat, stable=True)
    e_sorted = e_flat[order]
    counts = jnp.bincount(e_flat, length=N_EXPERTS)
    padded = (counts + EXPERT_BLOCK - 1) // EXPERT_BLOCK * EXPERT_BLOCK
    start = jnp.cumsum(counts) - counts
    pend = jnp.cumsum(padded)
    pstart = pend - padded
    dest = pstart[e_sorted] + (jnp.arange(T * TOP_K, dtype=jnp.int32) - start[e_sorted])
    n_rows = T * TOP_K + N_EXPERTS * EXPERT_BLOCK
    n_blocks = n_rows // EXPERT_BLOCK
    row_tok = jnp.full((n_rows,), T, jnp.int32).at[dest].set(tok_flat[order])
    row_w = jnp.zeros((n_rows,), jnp.float32).at[dest].set(w_flat[order]).astype(xn.dtype)
    blk_e = jnp.minimum(jnp.searchsorted(pend, jnp.arange(n_blocks) * EXPERT_BLOCK, side='right'),
                        N_EXPERTS - 1).astype(jnp.int32)
    x_pad = jnp.concatenate([xt, jnp.zeros((1, D), xt.dtype)], axis=0)
    xb = x_pad[row_tok].reshape(n_blocks, EXPERT_BLOCK, D)

    def expert_block(args):
        x_blk, e = args
        gu = x_blk @ w_gu[e] + b_gu[e]
        gate, up = jnp.split(gu, 2, axis=-1)
        gate = jnp.minimum(gate, SWIGLU_LIMIT)
        up = jnp.clip(up, -SWIGLU_LIMIT, SWIGLU_LIMIT)
        glu = gate * jax.nn.sigmoid(SWIGLU_ALPHA * gate)
        return ((up + 1.0) * glu) @ w_down[e] + b_down[e]

    yb = lax.map(expert_block, (xb, blk_e))
    y_rows = yb.reshape(n_rows, D) * row_w[:, None]
    y = jax.ops.segment_sum(y_rows, row_tok, num_segments=T + 1)[:T]
    return y.reshape(B, S, D)


def setup_inputs(seed: int = 0) -> dict:
    key = jax.random.key(seed)
    ks = jax.random.split(key, 32)
    L, D = DEPTH, D_MODEL

    def nrm(k, shape, s):
        return jax.random.normal(k, shape, jnp.float32) * s

    a_pow = jax.random.uniform(ks[16], (L, RNN_WIDTH), jnp.float32, LRU_A_MIN, LRU_A_MAX)
    a = a_pow ** (1.0 / RG_C)
    rg_lambda = jnp.log(a) - jnp.log1p(-a)
    return {
        "x": nrm(ks[0], (BATCH, SEQ, D), 1.0),
        "c": nrm(ks[1], (BATCH, D), 1.0),
        "ada_w": nrm(ks[2], (L, D, 6 * D), 0.2 * D ** -0.5),
        "ada_b": nrm(ks[3], (L, 6 * D), 0.02),
        "norm1_g": 1.0 + nrm(ks[4], (L, D), 0.02),
        "w_in": nrm(ks[5], (L, D, IN_WIDTH), D ** -0.5),
        "q_norm_g": 1.0 + nrm(ks[6], (L, ATTN_HEAD_DIM), 0.02),
        "k_norm_g": 1.0 + nrm(ks[7], (L, ATTN_HEAD_DIM), 0.02),
        "rel_bias": nrm(ks[8], (L, ATTN_HEADS, REL_SIZE), 0.5),
        "conv_w": nrm(ks[9], (L, CONV_W, RNN_WIDTH), CONV_W ** -0.5),
        "conv_b": nrm(ks[10], (L, RNN_WIDTH), 0.02),
        "rg_a_w": nrm(ks[11], (L, RNN_BLOCKS, RNN_BLOCK_W, RNN_BLOCK_W), RNN_BLOCK_W ** -0.5),
        "rg_a_b": nrm(ks[12], (L, RNN_BLOCKS, RNN_BLOCK_W), 0.02),
        "rg_x_w": nrm(ks[13], (L, RNN_BLOCKS, RNN_BLOCK_W, RNN_BLOCK_W), RNN_BLOCK_W ** -0.5),
        "rg_x_b": nrm(ks[14], (L, RNN_BLOCKS, RNN_BLOCK_W), 0.02),
        "rg_lambda": rg_lambda,
        "w_attn_up": nrm(ks[17], (L, ATTN_WIDTH, D), ATTN_WIDTH ** -0.5),
        "w_rnn_up": nrm(ks[18], (L, RNN_WIDTH, D), RNN_WIDTH ** -0.5),
        "w_out": nrm(ks[19], (L, D, D), D ** -0.5),
        "norm2_g": 1.0 + nrm(ks[20], (L, D), 0.02),
        "w_router": nrm(ks[21], (L, D, N_EXPERTS), D ** -0.5),
        "b_router": nrm(ks[22], (L, N_EXPERTS), 0.01),
        "w_gu": nrm(ks[23], (L, N_EXPERTS, D, 2 * D_FF), D ** -0.5),
        "b_gu": nrm(ks[24], (L, N_EXPERTS, 2 * D_FF), 0.02),
        "w_down": nrm(ks[25], (L, N_EXPERTS, D_FF, D), D_FF ** -0.5),
        "b_down": nrm(ks[26], (L, N_EXPERTS, D), 0.02),
    }


def reference(x, c, ada_w, ada_b, norm1_g, w_in, q_norm_g, k_norm_g, rel_bias, conv_w, conv_b,
              rg_a_w, rg_a_b, rg_x_w, rg_x_b, rg_lambda, w_attn_up, w_rnn_up, w_out, norm2_g,
              w_router, b_router, w_gu, b_gu, w_down, b_down):
    B, S, D = x.shape
    h = x
    c_act = jax.nn.silu(c)
    for l in range(DEPTH):
        mod = c_act @ ada_w[l] + ada_b[l]
        sh1, sc1, g1, sh2, sc2, g2 = jnp.split(mod, 6, axis=-1)

        xn = rms_norm(h, norm1_g[l]) * (1.0 + sc1[:, None, :]) + sh1[:, None, :]
        proj = xn @ w_in[l]
        q, k, v, rx, rgate, ga, gb = jnp.split(proj, SPLIT_POINTS, axis=-1)
        q = rms_norm(q.reshape(B, S, ATTN_HEADS, ATTN_HEAD_DIM), q_norm_g[l])
        k = rms_norm(k.reshape(B, S, ATTN_HEADS, ATTN_HEAD_DIM), k_norm_g[l])
        v = v.reshape(B, S, ATTN_HEADS, ATTN_HEAD_DIM)
        y_a = chunked_band_attention(q, k, v, rel_bias[l])
        xc = causal_depthwise_conv(rx, conv_w[l], conv_b[l])
        y_b = rg_lru(xc, rg_a_w[l], rg_a_b[l], rg_x_w[l], rg_x_b[l], rg_lambda[l]) * jax.nn.gelu(rgate)
        merged = jax.nn.sigmoid(ga) * (y_a @ w_attn_up[l]) + jax.nn.sigmoid(gb) * (y_b @ w_rnn_up[l])
        h = h + g1[:, None, :] * (merged @ w_out[l])

        hn = rms_norm(h, norm2_g[l]) * (1.0 + sc2[:, None, :]) + sh2[:, None, :]
        y_ffn = moe_ffn(hn, w_router[l], b_router[l], w_gu[l], b_gu[l], w_down[l], b_down[l])
        h = h + g2[:, None, :] * y_ffn
    return h
```

```cpp
#define LAS __attribute__((address_space(3)))
#include <hip/hip_runtime.h>
#include <cstdio>
#include <cstdint>
namespace pg8 {
#define PG8_LAS __attribute__((address_space(3)))
typedef unsigned short bf16_t;
typedef short bf16x8 __attribute__((ext_vector_type(8)));
typedef float f32x4 __attribute__((ext_vector_type(4)));
typedef unsigned u32x4 __attribute__((ext_vector_type(4)));
typedef int v8i32 __attribute__((ext_vector_type(8)));
typedef short s16x16 __attribute__((ext_vector_type(16)));
constexpr int BM = 256, BK = 64, HALF = 128, HTB = HALF * BK * 2  , STAGE_BYTES = 8 * HTB, NXCD = 8, WGM = 4;

__host__ __device__ __forceinline__ int lds_byte(int r, int c) { const int st = (r >> 4) * 2 + (c >> 5), rr = r & 15, cc = c & 31, ob = rr * 64 + cc * 2; return st * 1024 + (ob ^ (((ob >> 9) & 1) << 5)); }
__host__ __device__ __forceinline__ void stage_rc(int b, int& R, int& C) { const int st = b / 1024, sb = b % 1024, swz = sb ^ (((sb >> 9) & 1) << 5); R = (st >> 1) * 16 + swz / 64; C = (st & 1) * 32 + (swz % 64) / 2; }
__host__ __device__ __forceinline__ int perm32(int rho) { const int n = rho >> 4, i = rho & 15; return 8 * (i >> 2) + 4 * n + (i & 3); }

struct Unit { int pm, pn, e; };
struct Gemm { const bf16_t* A; const bf16_t* Bt; int M, N, K; size_t estride; int rowtab; unsigned* rs_cnt; unsigned rs_n; int rs_rounds; int lda, ldb; };

struct StaticOrder {
    int nM, nN, nwg, G, c;
    __host__ __device__ void init(int M, int N, int G_, int c_) { nM = M / BM; nN = N / BM; nwg = nM * nN; G = G_; c = c_; }
    __host__ __device__ bool next(int i, Unit& u) const {
        const long L = (long)i * G + c; if (L >= nwg) return false;
        int wgid = (int)L; { const int q = nwg / NXCD, r = nwg % NXCD, xcd = wgid % NXCD, off = wgid / NXCD; wgid = (xcd < r ? xcd * (q + 1) : r * (q + 1) + (xcd - r) * q) + off; }
        const int nig = WGM * nN, gid = wgid / nig, fm = gid * WGM, gsz = (nM - fm) < WGM ? (nM - fm) : WGM;
        u.pm = fm + ((wgid % nig) % gsz); u.pn = (wgid % nig) / gsz; u.e = 0; return true;
    }
    __device__ __forceinline__ void a_ready(const Unit&) const {}
    __device__ __forceinline__ void done(const Unit&) const {}
};

__device__ __forceinline__ unsigned cvt_pk_bf16(float lo, float hi) { unsigned r; asm volatile("v_cvt_pk_bf16_f32 %0, %1, %2" : "=v"(r) : "v"(lo), "v"(hi)); return r; }
typedef float f32x2 __attribute__((ext_vector_type(2)));
template <class Epi, class Sched, bool ALIGN_EPI = false, bool SP2 = false, bool BBLK = false, bool F8 = false, bool GATHER = false>
__device__ __forceinline__ void gemm_phase(PG8_LAS unsigned char* lds, const Gemm g, const Sched& S, const Epi& E) {
    const int tid = threadIdx.x, wid = __builtin_amdgcn_readfirstlane(tid >> 6), lane = tid & 63, wr = wid >> 2, wc = wid & 3, fr = lane & 15, fq = lane >> 4;
    const int K = g.K, nt = K / BK;
    const int lda = g.lda ? g.lda : K * 2, ldb = g.ldb ? g.ldb : K * 2;
    unsigned voffA[2], voffB[2]; int Rst[2]; unsigned Cst[2];
#pragma unroll
    for (int i = 0; i < 2; ++i) { int R, C; stage_rc(tid * 16 + i * 8192, R, C); const int Rb = Epi::PERM ? ((R & ~31) + perm32(R & 31)) : R;
        Rst[i] = R; Cst[i] = (unsigned)C * 2u; voffA[i] = (unsigned)(R * lda) + (unsigned)C * 2u; voffB[i] = BBLK ? (unsigned)(tid * 16 + i * 8192) : (unsigned)(Rb * ldb) + (unsigned)C * 2u; }
    const size_t kstep = (size_t)(BK * 2);
    const size_t hstep = (size_t)HALF * lda;
    const size_t kstepB = BBLK ? (size_t)32768 : kstep, hstepB = BBLK ? (size_t)16384 : (size_t)HALF * ldb, tstepB = BBLK ? (size_t)nt * 32768 : 2 * hstepB;
    const size_t tstep = 2 * hstep;
    const unsigned ldsw = (unsigned)wid * 1024u;
    const int aoff = lds_byte(wr * 64 + fr, fq * 8), boff = lds_byte(wc * 32 + fr, fq * 8);
#define PG8_SA(b, h) (((b) * 2 + (h)) * HTB)
#define PG8_SB(b, h) ((4 + (b) * 2 + (h)) * HTB)
#define PG8_STAGE(bufoff, gbase, voff) do { _Pragma("unroll") for (int _i = 0; _i < 2; ++_i) \
        __builtin_amdgcn_global_load_lds((const unsigned*)((const char*)(gbase) + (voff)[_i]), (PG8_LAS unsigned*)(lds + (bufoff) + ldsw + _i * 8192), 16, 0, 0); } while (0)
#define PG8_STAGEA(bufoff, gbase, h, usen) do { if constexpr (GATHER) { _Pragma("unroll") for (int _i = 0; _i < 2; ++_i) { const unsigned _v = (usen) ? nvA[h][_i] : vA[h][_i]; \
        __builtin_amdgcn_global_load_lds((const unsigned*)((const char*)(gbase) + _v), (PG8_LAS unsigned*)(lds + (bufoff) + ldsw + _i * 8192), 16, 0, 0); } } \
    else { PG8_STAGE(bufoff, (gbase) + ((h) ? hstep : 0), voffA); } } while (0)
#define PG8_ROWV(dst, uidx) do { _Pragma("unroll") for (int _h = 0; _h < 2; ++_h) _Pragma("unroll") for (int _i = 0; _i < 2; ++_i) \
        dst[_h][_i] = (unsigned)(*(const PG8_LAS int*)(lds + g.rowtab + ((uidx) * 256 + _h * 128 + Rst[_i]) * 4)) * (unsigned)lda + Cst[_i]; } while (0)
#define PG8_CAT16(lo, hi) __builtin_shufflevector(lo, hi, 0, 1, 2, 3, 4, 5, 6, 7, 8, 9, 10, 11, 12, 13, 14, 15)
#define PG8_LDA(dst, b, h) do { if constexpr (F8) { _Pragma("unroll") for (int m = 0; m < 4; ++m) { const bf16x8 _lo = *(const PG8_LAS bf16x8*)(lds + PG8_SA(b, h) + aoff + m * 2048), _hi = *(const PG8_LAS bf16x8*)(lds + PG8_SA(b, h) + aoff + m * 2048 + 1024); dst##x[m] = PG8_CAT16(_lo, _hi); } } \
        else { _Pragma("unroll") for (int m = 0; m < 4; ++m) _Pragma("unroll") for (int k = 0; k < 2; ++k) dst[m][k] = *(const PG8_LAS bf16x8*)(lds + PG8_SA(b, h) + aoff + m * 2048 + k * 1024); } } while (0)
#define PG8_LDB(dst, b, h) do { if constexpr (F8) { _Pragma("unroll") for (int n = 0; n < 2; ++n) { const bf16x8 _lo = *(const PG8_LAS bf16x8*)(lds + PG8_SB(b, h) + boff + n * 2048), _hi = *(const PG8_LAS bf16x8*)(lds + PG8_SB(b, h) + boff + n * 2048 + 1024); dst##x[n] = PG8_CAT16(_lo, _hi); } } \
        else { _Pragma("unroll") for (int n = 0; n < 2; ++n) _Pragma("unroll") for (int k = 0; k < 2; ++k) dst[n][k] = *(const PG8_LAS bf16x8*)(lds + PG8_SB(b, h) + boff + n * 2048 + k * 1024); } } while (0)
#define PG8_MMA(ai, bj, At, Bt) do { __builtin_amdgcn_s_setprio(1); if constexpr (F8) { \
        _Pragma("unroll") for (int m = 0; m < 4; ++m) _Pragma("unroll") for (int n = 0; n < 2; ++n) \
            asm volatile("v_mfma_scale_f32_16x16x128_f8f6f4 %0, %1, %2, %0, %3, %3 op_sel_hi:[0,0,0]" : "+v"(acc[ai][bj][m][n]) : "v"(Bt##x[n]), "v"(At##x[m]), "v"(f8one)); \
        } else { _Pragma("unroll") for (int m = 0; m < 4; ++m) _Pragma("unroll") for (int n = 0; n < 2; ++n) _Pragma("unroll") for (int k = 0; k < 2; ++k) \
        acc[ai][bj][m][n] = __builtin_amdgcn_mfma_f32_16x16x32_bf16(Bt[n][k], At[m][k], acc[ai][bj][m][n], 0, 0, 0); } __builtin_amdgcn_s_setprio(0); } while (0)
#define PG8_MMAZ(ai, bj, At, Bt) do { __builtin_amdgcn_s_setprio(1); \
        _Pragma("unroll") for (int m = 0; m < 4; ++m) _Pragma("unroll") for (int n = 0; n < 2; ++n) \
            asm volatile("v_mfma_scale_f32_16x16x128_f8f6f4 %0, %1, %2, 0, %3, %3 op_sel_hi:[0,0,0]" : "=&v"(acc[ai][bj][m][n]) : "v"(Bt##x[n]), "v"(At##x[m]), "v"(f8one)); \
        __builtin_amdgcn_s_setprio(0); } while (0)
#define PG8_MMA0(ai, bj, At, Bt) do { if constexpr (F8 && SP2) { if (t == 0) PG8_MMAZ(ai, bj, At, Bt); else PG8_MMA(ai, bj, At, Bt); } else PG8_MMA(ai, bj, At, Bt); } while (0)
#define PG8_WAIT_V(n) asm volatile("s_waitcnt vmcnt(" #n ")" ::: "memory")
#define PG8_WAIT_VS() do { if constexpr (Epi::NST > 0) { if (wsel == 1) asm volatile("s_waitcnt vmcnt(%0)" :: "n"(8 + Epi::NST) : "memory"); else if (wsel == 2) PG8_WAIT_V(9); else PG8_WAIT_V(8); } else PG8_WAIT_V(8); } while (0)
#define PG8_WAIT_L(n) asm volatile("s_waitcnt lgkmcnt(" #n ")" ::: "memory")
#define PG8_BAR __builtin_amdgcn_s_barrier()
#define PG8_SCHED __builtin_amdgcn_sched_barrier(0)
    Unit cur, nxt; int ui = 0;
    if (!S.next(0, cur)) return;
    f32x4 acc[2][2][4][2];
    if constexpr (!(F8 && SP2))
#pragma unroll
    for (int a = 0; a < 2; ++a)
#pragma unroll
        for (int b = 0; b < 2; ++b)
#pragma unroll
            for (int m = 0; m < 4; ++m)
#pragma unroll
                for (int n = 0; n < 2; ++n) acc[a][b][m][n] = (f32x4){0.f, 0.f, 0.f, 0.f};
    bf16x8 At[4][2], B0[2][2], B1[2][2];
    s16x16 Atx[4], B0x[2], B1x[2];
    const int f8one = 0x7f7f7f7f;
    unsigned vA[2][2], nvA[2][2];
    if constexpr (GATHER) { PG8_ROWV(vA, 0); PG8_ROWV(nvA, 0); } else { vA[0][0] = vA[0][1] = vA[1][0] = vA[1][1] = 0u; nvA[0][0] = nvA[0][1] = nvA[1][0] = nvA[1][1] = 0u; }
    const char* cA = (const char*)g.A + (GATHER ? (size_t)0 : (size_t)cur.pm * tstep); const char* cB = (const char*)g.Bt + (size_t)cur.pn * tstepB + (size_t)cur.e * g.estride;
    S.a_ready(cur);
    if constexpr (SP2) {
        PG8_STAGE(PG8_SB(0, 0), cB, voffB); PG8_STAGE(PG8_SB(0, 1), cB + hstepB, voffB); PG8_STAGEA(PG8_SA(0, 0), cA, 0, false); PG8_STAGEA(PG8_SA(0, 1), cA, 1, false);
        if (wr == 1) PG8_BAR;
        PG8_WAIT_V(2); PG8_BAR;
        PG8_STAGE(PG8_SB(1, 0), cB + kstepB, voffB); PG8_STAGEA(PG8_SA(1, 0), cA + kstep, 0, false); PG8_STAGE(PG8_SB(1, 1), cB + hstepB + kstepB, voffB);
        PG8_WAIT_V(6); PG8_BAR;
    } else {
        PG8_STAGE(PG8_SB(0, 0), cB, voffB); PG8_STAGEA(PG8_SA(0, 0), cA, 0, false); PG8_STAGE(PG8_SB(0, 1), cB + hstepB, voffB); PG8_STAGEA(PG8_SA(0, 1), cA, 1, false);
        if (wr == 1) PG8_BAR;
        PG8_WAIT_V(4); PG8_BAR;
        PG8_STAGE(PG8_SB(1, 0), cB + kstepB, voffB); PG8_STAGEA(PG8_SA(1, 0), cA + kstep, 0, false); PG8_STAGE(PG8_SB(1, 1), cB + hstepB + kstepB, voffB);
        PG8_WAIT_V(6); PG8_BAR;
    }
    for (;;) {
        const bool has_next = S.next(ui + 1, nxt);
        if (g.rs_cnt != nullptr && ui >= 1 && ui < g.rs_rounds && tid == 0) {
            __hip_atomic_fetch_add(g.rs_cnt, 1u, __ATOMIC_RELAXED, __HIP_MEMORY_SCOPE_AGENT);
            const unsigned target = (unsigned)ui * g.rs_n; unsigned sp = 0;
            while (__hip_atomic_load(g.rs_cnt, __ATOMIC_RELAXED, __HIP_MEMORY_SCOPE_AGENT) < target && ++sp < 4096u) __builtin_amdgcn_s_sleep(4);
        }
        if constexpr (GATHER) { if (has_next) { PG8_ROWV(nvA, ui + 1); } else { nvA[0][0] = vA[0][0]; nvA[0][1] = vA[0][1]; nvA[1][0] = vA[1][0]; nvA[1][1] = vA[1][1]; } }
        const char* nA = has_next ? (const char*)g.A + (GATHER ? (size_t)0 : (size_t)nxt.pm * tstep) : cA; const char* nB = has_next ? (const char*)g.Bt + (size_t)nxt.pn * tstepB + (size_t)nxt.e * g.estride : cB;
        for (int t = 0; t < nt; t += 2) {
            const bool last = (t == nt - 2);
            const char* a1 = cA + (size_t)(t + 1) * kstep;
            const char* a2 = last ? nA : cA + (size_t)(t + 2) * kstep; const char* b2 = last ? nB : cB + (size_t)(t + 2) * kstepB;
            const char* a3 = a2 + kstep; const char* b3 = b2 + kstepB;
            if (last && has_next) S.a_ready(nxt);
            const int wsel = (t == 0 && ui > 0 && !last) ? 1 : ((last && Epi::LDSOPS) ? 2 : 0);
            if constexpr (Epi::LDSOPS) { if (last) E.prefetch(cur, wid, lane); }
            if constexpr (SP2) {
            PG8_LDB(B0, 0, 0); PG8_LDB(B1, 0, 1); PG8_SCHED; PG8_LDA(At, 0, 0); PG8_STAGEA(PG8_SA(1, 1), a1, 1, false);
            PG8_WAIT_VS(); PG8_WAIT_L(0); PG8_BAR; PG8_MMA0(0, 0, At, B0); PG8_MMA0(0, 1, At, B1); PG8_BAR; PG8_SCHED;
            PG8_LDA(At, 0, 1); PG8_STAGE(PG8_SB(0, 0), b2, voffB); PG8_STAGE(PG8_SB(0, 1), b2 + hstepB, voffB); PG8_STAGEA(PG8_SA(0, 0), a2, 0, last);
            PG8_WAIT_VS(); PG8_WAIT_L(0); PG8_BAR; PG8_MMA0(1, 0, At, B0); PG8_MMA0(1, 1, At, B1); PG8_BAR; PG8_SCHED;
            PG8_LDB(B0, 1, 0); PG8_LDB(B1, 1, 1); PG8_SCHED; PG8_LDA(At, 1, 0); PG8_STAGEA(PG8_SA(0, 1), a2, 1, last);
            PG8_WAIT_V(8); PG8_WAIT_L(0); PG8_BAR; PG8_MMA(0, 0, At, B0); PG8_MMA(0, 1, At, B1); PG8_BAR; PG8_SCHED;
            PG8_LDA(At, 1, 1); PG8_STAGE(PG8_SB(1, 0), b3, voffB); PG8_STAGE(PG8_SB(1, 1), b3 + hstepB, voffB); PG8_STAGEA(PG8_SA(1, 0), a3, 0, last);
            PG8_WAIT_V(8); PG8_WAIT_L(0); PG8_BAR; PG8_MMA(1, 0, At, B0); PG8_MMA(1, 1, At, B1); PG8_BAR; PG8_SCHED;
            } else {
            PG8_LDB(B0, 0, 0); PG8_SCHED; PG8_LDA(At, 0, 0); PG8_STAGEA(PG8_SA(1, 1), a1, 1, false);
            PG8_WAIT_L(8); PG8_BAR; PG8_WAIT_L(0); PG8_MMA(0, 0, At, B0); PG8_BAR; PG8_SCHED;
            PG8_LDB(B1, 0, 1); PG8_STAGE(PG8_SB(0, 0), b2, voffB);
            PG8_BAR; PG8_WAIT_L(0); PG8_MMA(0, 1, At, B1); PG8_BAR;
            PG8_LDA(At, 0, 1); PG8_STAGEA(PG8_SA(0, 0), a2, 0, last);
            PG8_BAR; PG8_WAIT_L(0); PG8_MMA(1, 0, At, B0); PG8_BAR; PG8_SCHED;
            PG8_STAGE(PG8_SB(0, 1), b2 + hstepB, voffB);
            PG8_WAIT_V(6); PG8_BAR; PG8_MMA(1, 1, At, B1); PG8_BAR;
            PG8_LDB(B0, 1, 0); PG8_SCHED; PG8_LDA(At, 1, 0); PG8_STAGEA(PG8_SA(0, 1), a2, 1, last);
            PG8_WAIT_L(8); PG8_BAR; PG8_WAIT_L(0); PG8_MMA(0, 0, At, B0); PG8_BAR; PG8_SCHED;
            PG8_LDB(B1, 1, 1); PG8_STAGE(PG8_SB(1, 0), b3, voffB);
            PG8_BAR; PG8_WAIT_L(0); PG8_MMA(0, 1, At, B1); PG8_BAR;
            PG8_LDA(At, 1, 1); PG8_STAGEA(PG8_SA(1, 0), a3, 0, last);
            PG8_BAR; PG8_WAIT_L(0); PG8_MMA(1, 0, At, B0); PG8_BAR; PG8_SCHED;
            PG8_STAGE(PG8_SB(1, 1), b3 + hstepB, voffB);
            PG8_WAIT_V(6); PG8_BAR; PG8_MMA(1, 1, At, B1); PG8_BAR;
            }
        }
        if constexpr (F8) { asm volatile("s_nop 15\n\ts_nop 15" ::: "memory"); }
        if constexpr (ALIGN_EPI) { if (wr == 0) PG8_BAR; }
        if constexpr (!Epi::AFTER_DRAIN) { E(acc, cur, wr, wc, fr, fq); S.done(cur); }
        if (!has_next) break;
        if constexpr (!(F8 && SP2))
#pragma unroll
        for (int a = 0; a < 2; ++a)
#pragma unroll
            for (int b = 0; b < 2; ++b)
#pragma unroll
                for (int m = 0; m < 4; ++m)
#pragma unroll
                    for (int n = 0; n < 2; ++n) acc[a][b][m][n] = (f32x4){0.f, 0.f, 0.f, 0.f};
        cur = nxt; cA = nA; cB = nB; ++ui; if constexpr (GATHER) { vA[0][0] = nvA[0][0]; vA[0][1] = nvA[0][1]; vA[1][0] = nvA[1][0]; vA[1][1] = nvA[1][1]; }
        if constexpr (ALIGN_EPI) { if (wr == 1) PG8_BAR; }
    }
    PG8_WAIT_V(0);
    if constexpr (!ALIGN_EPI) { if (wr == 0) PG8_BAR; }
    PG8_BAR;
    if constexpr (Epi::AFTER_DRAIN) { E.fused(acc, cur, wr, wc, fr, fq, lds, wid, lane); S.done(cur); }
#undef PG8_SA
#undef PG8_SB
#undef PG8_STAGE
#undef PG8_STAGEA
#undef PG8_ROWV
#undef PG8_CAT16
#undef PG8_LDA
#undef PG8_LDB
#undef PG8_MMA
#undef PG8_MMAZ
#undef PG8_MMA0
#undef PG8_WAIT_V
#undef PG8_WAIT_VS
#undef PG8_WAIT_L
#undef PG8_BAR
#undef PG8_SCHED
}
}
#define XB_TMO      128
#define XB_XCNT(j)  (256  + 64 * (j))
#define XB_XSUB(j)  (1280 + 64 * (j))
#define XB_XGEN(j)  (2304 + 64 * (j))
#define XB_TOP      3328
#define XB_TOPGEN   3392
#define XCD_BAR_WORDS 3456
#define XB_SPIN_CAP (1u << 18)

__device__ __forceinline__ unsigned xb_ld(unsigned* p)              { return __hip_atomic_load(p, __ATOMIC_RELAXED, __HIP_MEMORY_SCOPE_AGENT); }
__device__ __forceinline__ unsigned xb_add(unsigned* p, unsigned v) { return __hip_atomic_fetch_add(p, v, __ATOMIC_RELAXED, __HIP_MEMORY_SCOPE_AGENT); }
__device__ __forceinline__ unsigned xb_xcc_id() { return (unsigned)__builtin_amdgcn_s_getreg((3 << 11) | 20) & 0xFu; }
#define XB_SPIN(cond, bar) do { unsigned _sp = 0; while (cond) { __builtin_amdgcn_s_sleep(1); \
    if ((++_sp & 255u) == 0u) { if (xb_ld(&(bar)[XB_TMO])) break; if (_sp > XB_SPIN_CAP) { atomicAdd(&(bar)[XB_TMO], 1u); break; } } } } while (0)

struct XcdBarrier {
    unsigned* bar; unsigned x;
    volatile LAS unsigned* st;
};

__device__ __forceinline__ XcdBarrier xcd_barrier_post(unsigned* bar, volatile LAS unsigned* st) {
    XcdBarrier b; b.bar = bar; b.x = xb_xcc_id(); b.st = st;
    if (threadIdx.x == 0) (void)xb_add(&bar[XB_XCNT(b.x)], 1u);
    return b;
}
__device__ __forceinline__ void xcd_barrier_complete(unsigned* bar, unsigned x, unsigned& nloc, unsigned& nx) {
    const unsigned G = gridDim.x * gridDim.y * gridDim.z;
    unsigned sum, cnt, mine, sp = 0u;
    for (;;) {
        sum = 0u; cnt = 0u; mine = 0u;
#pragma unroll
        for (unsigned j = 0; j < 16; ++j) { const unsigned c = xb_ld(&bar[XB_XCNT(j)]); sum += c; cnt += (c > 0u) ? 1u : 0u; mine = (j == x) ? c : mine; }
        if (sum == G) break;
        __builtin_amdgcn_s_sleep(1);
        if ((++sp & 255u) == 0u) { if (xb_ld(&bar[XB_TMO])) break; if (sp > XB_SPIN_CAP) { atomicAdd(&bar[XB_TMO], 1u); break; } }
    }
    nloc = mine > 0u ? mine : 1u; nx = cnt > 0u ? cnt : 1u;
}

__device__ __forceinline__ void xcd_barrier(const XcdBarrier& b) {
    asm volatile("s_waitcnt vmcnt(0)" ::: "memory");
    __syncthreads();
    if (threadIdx.x == 0) {
        unsigned* bar = b.bar;
        __builtin_amdgcn_s_waitcnt(0);
        unsigned nloc = b.st[0], nx = b.st[1];
        if (nloc == 0u) { xcd_barrier_complete(bar, b.x, nloc, nx); b.st[0] = nloc; b.st[1] = nx; }
        const unsigned old = xb_add(&bar[XB_XSUB(b.x)], 1u);
        const unsigned gen = old / nloc;
        if (old + 1u == (gen + 1u) * nloc) {
            __builtin_amdgcn_fence(__ATOMIC_RELEASE, "agent");
            asm volatile("s_waitcnt vmcnt(0)" ::: "memory");
            const unsigned og = xb_add(&bar[XB_TOP], 1u);
            const unsigned tg = og / nx;
            if (og + 1u == (tg + 1u) * nx) xb_add(&bar[XB_TOPGEN], 1u);
            else XB_SPIN(xb_ld(&bar[XB_TOPGEN]) == tg, bar);
            __builtin_amdgcn_fence(__ATOMIC_ACQUIRE, "agent");
            xb_add(&bar[XB_XGEN(b.x)], 1u);
            asm volatile("s_waitcnt vmcnt(0)" ::: "memory");
        } else {
            XB_SPIN(xb_ld(&bar[XB_XGEN(b.x)]) == gen, bar);
            __builtin_amdgcn_fence(__ATOMIC_ACQUIRE, "agent");
            asm volatile("s_waitcnt vmcnt(0)" ::: "memory");
        }
    }
    __syncthreads();
}

constexpr int NWAVES = 8;
constexpr int T_ = 16384, D_ = 2048, NH = 8, HD = 128, AW = 1024, RW = 1024, NE = 32, TOPK = 4, DFF = 2048;
constexpr int INW = 9216, PW = 8192;
constexpr int PQ = 0, PK = 1024, PRX = 2048, PRG = 3072, PGA = 4096, PGB = 6144;
constexpr int NROWS = T_ * TOPK + NE * 256, NBLK = NROWS / 256;
constexpr int NSEG = 256, SEG = 64;
constexpr float EPS_ = 1e-6f;
constexpr int N_PHASES = 12;
#ifndef MOE_CVT_IN_GEMM
#define MOE_CVT_IN_GEMM 0
#endif
#ifndef MOE_FP8
#define MOE_FP8 1
#endif
#ifndef INPROJ_FP8
#define INPROJ_FP8 1
#endif
#ifndef MIX_FP8
#define MIX_FP8 1
#endif
#ifndef ROUND_SYNC
#define ROUND_SYNC 0
#endif
#ifndef WPITCH
#define WPITCH 2176
#endif
#ifndef YD_FP8
#define YD_FP8 1
#endif
#ifndef MK_ONE_LAUNCH
#define MK_ONE_LAUNCH 1
#endif

constexpr size_t MiB = 1u << 20, KiB = 1u << 10;
constexpr size_t WS_CTL = 0, CTL_ZERO_BYTES = 1 * MiB;
constexpr size_t WS_MOD = 1 * MiB;
constexpr size_t WS_HIST = 1 * MiB + 64 * KiB;
constexpr size_t WS_PLAN = 1 * MiB + 128 * KiB;
constexpr size_t WS_TOPE = 2 * MiB, WS_TOPW = 2 * MiB + 256 * KiB, WS_POS = 2 * MiB + 512 * KiB;
constexpr size_t WS_ROWW = 3 * MiB + 512 * KiB;
constexpr size_t WS_ROWTOK = 3 * MiB;
constexpr size_t WS_SEGA = 4 * MiB, WS_SEGH = 5 * MiB;
constexpr size_t WS_WAT = 6 * MiB, WS_WXT = 6 * MiB + 256 * KiB;
constexpr size_t WS_WRT = 6 * MiB + 512 * KiB, WS_RB = 6 * MiB + 768 * KiB;
constexpr size_t WS_WIN = 8 * MiB;
constexpr size_t WS_WV = 40 * MiB;
constexpr size_t WS_WAU = 44 * MiB, WS_WRU = 48 * MiB;
constexpr size_t WS_WOUT = 52 * MiB;
constexpr size_t WS_WGU = 64 * MiB;
constexpr size_t WS_WDN = 576 * MiB;
constexpr size_t WS_XN = 832 * MiB;
constexpr size_t WS_P8 = 897 * MiB;
constexpr size_t WS_VT = 1153 * MiB;
constexpr size_t WS_YA = 1185 * MiB, WS_YB = 1217 * MiB;
constexpr size_t WS_T1 = 1249 * MiB;
constexpr size_t WS_MG = 1377 * MiB;
constexpr size_t WS_HL = 1441 * MiB, WS_AC = 1505 * MiB;
constexpr size_t WS_ACT = 1569 * MiB;
constexpr size_t WS_YD = 1857 * MiB;
constexpr size_t WS_XB = 2145 * MiB;
constexpr size_t WS_QH = 2433 * MiB, WS_KH = 2465 * MiB;
constexpr size_t WS_END = 2497 * MiB;
constexpr int CW_RS = 16384;
constexpr int CW_RANK = 12288;
#ifndef CVT_Q2
#define CVT_Q2 96
#endif
#ifndef CVT_HOST
#define CVT_HOST 2
#endif
constexpr int CW_Q = 24576;
constexpr int CW_BAR = 4096;

constexpr int LDS_BYTES = 163840, MISC_OFF = LDS_BYTES - 256, ROWTAB_OFF = 131072, EPI_OFF = 155648;

typedef unsigned short bf16;
typedef unsigned u32x2 __attribute__((ext_vector_type(2)));
typedef unsigned u32x4 __attribute__((ext_vector_type(4)));
typedef float f32x2 __attribute__((ext_vector_type(2)));
typedef float f32x4 __attribute__((ext_vector_type(4)));
typedef float f32x16 __attribute__((ext_vector_type(16)));
typedef short bf16x8 __attribute__((ext_vector_type(8)));
typedef __bf16 bf16x2_t __attribute__((ext_vector_type(2)));

__device__ __forceinline__ unsigned pk2(float lo, float hi) { f32x2 v = {lo, hi}; bf16x2_t b = __builtin_convertvector(v, bf16x2_t); return __builtin_bit_cast(unsigned, b); }
__device__ __forceinline__ float bflo(unsigned w) { return __uint_as_float(w << 16); }
__device__ __forceinline__ float bfhi(unsigned w) { return __uint_as_float(w & 0xffff0000u); }
__device__ __forceinline__ float sigmoidf_(float x) { return __builtin_amdgcn_rcpf(1.0f + __builtin_amdgcn_exp2f(-1.44269504089f * x)); }
__device__ __forceinline__ float gelu_tanh(float x) { const float u = -2.30220819813f * (x + 0.044715f * x * x * x); return x * __builtin_amdgcn_rcpf(1.0f + __builtin_amdgcn_exp2f(u)); }
__device__ __forceinline__ f32x2 sigmoid2(f32x2 x) { const f32x2 z = x * -1.44269504089f; const f32x2 d = (f32x2){__builtin_amdgcn_exp2f(z.x), __builtin_amdgcn_exp2f(z.y)} + 1.0f; return (f32x2){__builtin_amdgcn_rcpf(d.x), __builtin_amdgcn_rcpf(d.y)}; }
__device__ __forceinline__ f32x2 bf2(unsigned w) { return (f32x2){bflo(w), bfhi(w)}; }
__device__ __forceinline__ float clamp448(float x) { return fminf(fmaxf(x, -448.0f), 448.0f); }
__device__ __forceinline__ unsigned pk4_fp8(float a, float b, float c2, float d) {
    int p = 0; p = __builtin_amdgcn_cvt_pk_fp8_f32(clamp448(a), clamp448(b), p, false); p = __builtin_amdgcn_cvt_pk_fp8_f32(clamp448(c2), clamp448(d), p, true); return (unsigned)p; }
__device__ __forceinline__ unsigned pk4_fp8_nc(float a, float b, float c2, float d) {
    int p = 0; p = __builtin_amdgcn_cvt_pk_fp8_f32(a, b, p, false); p = __builtin_amdgcn_cvt_pk_fp8_f32(c2, d, p, true); return (unsigned)p; }
__device__ __forceinline__ float wave_sum(float v) {
#pragma unroll
    for (int o = 1; o < 64; o <<= 1) v += __shfl_xor(v, o);
    return v;
}
__device__ __forceinline__ int crow(int reg, int h) { return (reg & 3) + 8 * (reg >> 2) + 4 * h; }

struct Frame {
    LAS unsigned char* lds;
    int tid, lane, wave, G, bx, vbx;
    const float* in[26]; float* out; unsigned char* ws;
};
#define WSP(T, off) ((T*)(F.ws + (off)))

namespace pg8 {
struct EpiStoreBf16 {
    static constexpr bool PERM = true, AFTER_DRAIN = false;
    static constexpr int NST = 16; static constexpr bool LDSOPS = false;
    bf16_t* O; int ldc; float sc;
    __device__ __forceinline__ void operator()(const f32x4 (&acc)[2][2][4][2], const Unit& u, int wr, int wc, int fr, int fq) const {
        const int row0 = u.pm * BM + wr * 64 + fr, col0 = u.pn * BM + wc * 32 + 8 * fq;
#pragma unroll
        for (int ai = 0; ai < 2; ++ai)
#pragma unroll
            for (int m = 0; m < 4; ++m) { bf16_t* rowp = O + (size_t)(row0 + ai * HALF + m * 16) * ldc + col0;
#pragma unroll
                for (int bj = 0; bj < 2; ++bj) { const f32x4 v0 = acc[ai][bj][m][0] * sc, v1 = acc[ai][bj][m][1] * sc;
                    u32x4 w; w.x = pk2(v0[0], v0[1]); w.y = pk2(v0[2], v0[3]); w.z = pk2(v1[0], v1[1]); w.w = pk2(v1[2], v1[3]);
                    *(u32x4*)(rowp + bj * HALF) = w; } }
    }
};
struct EpiProj {
    static constexpr bool PERM = true, AFTER_DRAIN = false;
    static constexpr int NST = 0; static constexpr bool LDSOPS = false;
    bf16_t* O; int ldc; float sc; bf16_t* QH; bf16_t* KH; const float* qg; const float* kg; LAS float* red;
    __device__ __forceinline__ void operator()(const f32x4 (&acc)[2][2][4][2], const Unit& u, int wr, int wc, int fr, int fq) const {
        const int row0 = u.pm * BM + wr * 64 + fr;
        if (u.pn >= 8) {
            const int col0 = u.pn * BM + wc * 32 + 8 * fq;
#pragma unroll
            for (int ai = 0; ai < 2; ++ai)
#pragma unroll
                for (int m = 0; m < 4; ++m) { bf16_t* rowp = O + (size_t)(row0 + ai * HALF + m * 16) * ldc + col0;
#pragma unroll
                    for (int bj = 0; bj < 2; ++bj) { const f32x4 v0 = acc[ai][bj][m][0] * sc, v1 = acc[ai][bj][m][1] * sc;
                        u32x4 w; w.x = pk2(v0[0], v0[1]); w.y = pk2(v0[2], v0[3]); w.z = pk2(v1[0], v1[1]); w.w = pk2(v1[2], v1[3]);
                        *(u32x4*)(rowp + bj * HALF) = w; } }
            return;
        }
#pragma unroll
        for (int ai = 0; ai < 2; ++ai)
#pragma unroll
            for (int m = 0; m < 4; ++m)
#pragma unroll
                for (int bj = 0; bj < 2; ++bj) { const f32x4 v0 = acc[ai][bj][m][0] * sc, v1 = acc[ai][bj][m][1] * sc;
                    float ss = (v0[0] * v0[0] + v0[1] * v0[1]) + (v0[2] * v0[2] + v0[3] * v0[3]) + (v1[0] * v1[0] + v1[1] * v1[1]) + (v1[2] * v1[2] + v1[3] * v1[3]);
                    ss += __shfl_xor(ss, 16); ss += __shfl_xor(ss, 32);
                    if (fq == 0) red[((ai * HALF + wr * 64 + m * 16 + fr) * 2 + bj) * 4 + wc] = ss; }
        asm volatile("s_waitcnt lgkmcnt(0)" ::: "memory"); __builtin_amdgcn_s_barrier(); asm volatile("" ::: "memory");
        const bool isk = u.pn >= 4; const int hbase = (isk ? u.pn - 4 : u.pn) * 2, d0 = wc * 32 + 8 * fq;
        const float* gp = (isk ? kg : qg) + d0; const float gs = isk ? 1.0f : (0.08838834764831845f * 1.44269504089f);
        const f32x4 g0 = *(const f32x4*)gp * gs, g1 = *(const f32x4*)(gp + 4) * gs;
        bf16_t* dst = isk ? KH : QH;
#pragma unroll
        for (int ai = 0; ai < 2; ++ai)
#pragma unroll
            for (int m = 0; m < 4; ++m)
#pragma unroll
                for (int bj = 0; bj < 2; ++bj) { const int rl = ai * HALF + wr * 64 + m * 16 + fr; const f32x4 pr = *(const LAS f32x4*)(red + (rl * 2 + bj) * 4);
                    const float rs = rsqrtf(((pr[0] + pr[1]) + (pr[2] + pr[3])) * (1.0f / 128.0f) + 1e-6f) * sc;
                    const f32x4 v0 = acc[ai][bj][m][0] * rs * g0, v1 = acc[ai][bj][m][1] * rs * g1;
                    u32x4 w; w.x = pk2(v0[0], v0[1]); w.y = pk2(v0[2], v0[3]); w.z = pk2(v1[0], v1[1]); w.w = pk2(v1[2], v1[3]);
                    *(u32x4*)(dst + ((size_t)(hbase + bj) * 16384 + (size_t)(row0 + ai * HALF + m * 16)) * 128 + d0) = w; }
    }
};
struct EpiVtb {
    static constexpr bool PERM = true, AFTER_DRAIN = false;
    static constexpr int NST = 16; static constexpr bool LDSOPS = false;
    bf16_t* O; float sc;
    __device__ __forceinline__ void operator()(const f32x4 (&acc)[2][2][4][2], const Unit& u, int wr, int wc, int fr, int fq) const {
        const int row0 = u.pm * BM + wr * 64 + fr, col0 = u.pn * BM + wc * 32 + 8 * fq;
#pragma unroll
        for (int ai = 0; ai < 2; ++ai)
#pragma unroll
            for (int m = 0; m < 4; ++m) { const int R = row0 + ai * HALF + m * 16;
#pragma unroll
                for (int bj = 0; bj < 2; ++bj) { const int C = col0 + bj * HALF; const f32x4 v0 = acc[ai][bj][m][0] * sc, v1 = acc[ai][bj][m][1] * sc;
                    u32x4 w; w.x = pk2(v0[0], v0[1]); w.y = pk2(v0[2], v0[3]); w.z = pk2(v1[0], v1[1]); w.w = pk2(v1[2], v1[3]);
                    *(u32x4*)(O + ((((size_t)(R >> 7) * 256 + (C >> 6)) * 128 + (R & 127)) * 64 + (C & 63))) = w; } }
    }
};
struct EpiMerge1 {
    static constexpr bool PERM = true, AFTER_DRAIN = false;
    static constexpr int NST = 16; static constexpr bool LDSOPS = false;
    float* T1; const bf16_t* Gt; int ldg; float sc;
    __device__ __forceinline__ void operator()(const f32x4 (&acc)[2][2][4][2], const Unit& u, int wr, int wc, int fr, int fq) const {
        const int row0 = u.pm * BM + wr * 64 + fr, col0 = u.pn * BM + wc * 32 + 8 * fq;
        u32x4 gwv[2][4][2];
#pragma unroll
        for (int ai = 0; ai < 2; ++ai)
#pragma unroll
            for (int m = 0; m < 4; ++m)
#pragma unroll
                for (int bj = 0; bj < 2; ++bj) gwv[ai][m][bj] = *(const u32x4*)(Gt + (size_t)(row0 + ai * HALF + m * 16) * ldg + col0 + bj * HALF);
#pragma unroll
        for (int ai = 0; ai < 2; ++ai)
#pragma unroll
            for (int m = 0; m < 4; ++m) { const size_t row = (size_t)(row0 + ai * HALF + m * 16);
#pragma unroll
                for (int bj = 0; bj < 2; ++bj) { const int col = col0 + bj * HALF;
                    const u32x4 gw = gwv[ai][m][bj];
                    const f32x4 a0 = acc[ai][bj][m][0], a1 = acc[ai][bj][m][1];
                    const f32x2 p0 = sigmoid2(bf2(gw.x)) * ((f32x2){a0[0], a0[1]} * sc), p1 = sigmoid2(bf2(gw.y)) * ((f32x2){a0[2], a0[3]} * sc), p2 = sigmoid2(bf2(gw.z)) * ((f32x2){a1[0], a1[1]} * sc), p3 = sigmoid2(bf2(gw.w)) * ((f32x2){a1[2], a1[3]} * sc);
                    u32x4 tw; tw.x = pk2(p0.x, p0.y); tw.y = pk2(p1.x, p1.y); tw.z = pk2(p2.x, p2.y); tw.w = pk2(p3.x, p3.y);
                    *(u32x4*)((bf16_t*)T1 + row * 2048 + col) = tw; } }
    }
};
struct EpiMerge2 {
    static constexpr bool PERM = true, AFTER_DRAIN = false;
    static constexpr int NST = 8; static constexpr bool LDSOPS = false;
    const float* T1; const bf16_t* Gt; int ldg; bf16_t* MG; float sc;
    __device__ __forceinline__ void operator()(const f32x4 (&acc)[2][2][4][2], const Unit& u, int wr, int wc, int fr, int fq) const {
        const int row0 = u.pm * BM + wr * 64 + fr, col0 = u.pn * BM + wc * 32 + 8 * fq;
#pragma unroll
        for (int ai = 0; ai < 2; ++ai) {
        u32x4 gwv[4][2], twv[4][2];
#pragma unroll
            for (int m = 0; m < 4; ++m)
#pragma unroll
                for (int bj = 0; bj < 2; ++bj) { const size_t row = (size_t)(row0 + ai * HALF + m * 16); const int col = col0 + bj * HALF;
                    gwv[m][bj] = *(const u32x4*)(Gt + row * ldg + col); twv[m][bj] = *(const u32x4*)((const bf16_t*)T1 + row * 2048 + col); }
#pragma unroll
            for (int m = 0; m < 4; ++m) { const size_t row = (size_t)(row0 + ai * HALF + m * 16);
#pragma unroll
                for (int bj = 0; bj < 2; ++bj) { const int col = col0 + bj * HALF;
                    const u32x4 gw = gwv[m][bj];
                    const u32x4 tw = twv[m][bj];
                    const f32x4 a0 = acc[ai][bj][m][0], a1 = acc[ai][bj][m][1];
                    const f32x2 q0 = bf2(tw.x) + sigmoid2(bf2(gw.x)) * ((f32x2){a0[0], a0[1]} * sc), q1 = bf2(tw.y) + sigmoid2(bf2(gw.y)) * ((f32x2){a0[2], a0[3]} * sc), q2 = bf2(tw.z) + sigmoid2(bf2(gw.z)) * ((f32x2){a1[0], a1[1]} * sc), q3 = bf2(tw.w) + sigmoid2(bf2(gw.w)) * ((f32x2){a1[2], a1[3]} * sc);
                    const f32x4 o0 = {q0.x, q0.y, q1.x, q1.y}, o1 = {q2.x, q2.y, q3.x, q3.y};
#if MIX_FP8
                    const f32x4 s0 = o0 * 64.0f, s1 = o1 * 64.0f;
                    u32x2 w8; w8.x = pk4_fp8(s0[0], s0[1], s0[2], s0[3]); w8.y = pk4_fp8(s1[0], s1[1], s1[2], s1[3]);
                    *(u32x2*)((unsigned char*)MG + row * 2048 + col) = w8; } }
#else
                    u32x4 w; w.x = pk2(o0[0], o0[1]); w.y = pk2(o0[2], o0[3]); w.z = pk2(o1[0], o1[1]); w.w = pk2(o1[2], o1[3]);
                    *(u32x4*)(MG + row * 2048 + col) = w; } }
#endif
        }
    }
};
struct EpiOut {
    static constexpr bool PERM = false, AFTER_DRAIN = false;
    static constexpr int NST = 16; static constexpr bool LDSOPS = false;
    const float* X; const float* g1; float* H1; float sc;
    __device__ __forceinline__ void operator()(const f32x4 (&acc)[2][2][4][2], const Unit& u, int wr, int wc, int fr, int fq) const {
        const int row0 = u.pm * BM + wr * 64 + fr, col0 = u.pn * BM + wc * 32 + 4 * fq;
        f32x4 gv[2][2];
#pragma unroll
        for (int bj = 0; bj < 2; ++bj)
#pragma unroll
            for (int n = 0; n < 2; ++n) gv[bj][n] = *(const f32x4*)(g1 + col0 + bj * HALF + n * 16) * sc;
#pragma unroll
        for (int ai = 0; ai < 2; ++ai) {
            f32x4 xv[4][2][2];
#pragma unroll
            for (int m = 0; m < 4; ++m)
#pragma unroll
                for (int bj = 0; bj < 2; ++bj)
#pragma unroll
                    for (int n = 0; n < 2; ++n) xv[m][bj][n] = *(const f32x4*)(X + (size_t)(row0 + ai * HALF + m * 16) * 2048 + col0 + bj * HALF + n * 16);
#pragma unroll
            for (int m = 0; m < 4; ++m) { const size_t off = (size_t)(row0 + ai * HALF + m * 16) * 2048 + col0;
#pragma unroll
                for (int bj = 0; bj < 2; ++bj)
#pragma unroll
                    for (int n = 0; n < 2; ++n) *(f32x4*)(H1 + off + bj * HALF + n * 16) = xv[m][bj][n] + gv[bj][n] * acc[ai][bj][m][n]; }
        }
    }
};
struct EpiSwiGLU {
    static constexpr bool PERM = true, AFTER_DRAIN = false;
    static constexpr int NST = 0; static constexpr bool LDSOPS = false;
    const float* bgu; bf16_t* ACT;
    __device__ __forceinline__ void operator()(const f32x4 (&acc)[2][2][4][2], const Unit& u, int wr, int wc, int fr, int fq) const {
        const int row0 = u.pm * BM + wr * 64 + fr, colA = u.pn * HALF + wc * 32 + 8 * fq;
        const float* bb = bgu + (size_t)u.e * 4096 + colA;
        const f32x4 bg0 = *(const f32x4*)(bb), bg1 = *(const f32x4*)(bb + 4), bu0 = *(const f32x4*)(bb + 2048), bu1 = *(const f32x4*)(bb + 2048 + 4);
#pragma unroll
        for (int ai = 0; ai < 2; ++ai)
#pragma unroll
            for (int m = 0; m < 4; ++m) { const size_t row = (size_t)(row0 + ai * HALF + m * 16);
                f32x4 o[2];
#pragma unroll
                for (int n = 0; n < 2; ++n) { const f32x4 gt = acc[ai][0][m][n] + (n ? bg1 : bg0), up = acc[ai][1][m][n] + (n ? bu1 : bu0);
#pragma unroll
                    for (int j = 0; j < 4; ++j) { const float g = fminf(gt[j], 7.0f), uu = fminf(fmaxf(up[j], -7.0f), 7.0f);
                        o[n][j] = (uu + 1.0f) * (g * __builtin_amdgcn_rcpf(1.0f + __builtin_amdgcn_exp2f(-2.45546695959f * g))); } }
                u32x4 w; w.x = pk2(o[0][0], o[0][1]); w.y = pk2(o[0][2], o[0][3]); w.z = pk2(o[1][0], o[1][1]); w.w = pk2(o[1][2], o[1][3]);
                *(u32x4*)(ACT + row * 2048 + colA) = w; }
    }
};
struct EpiSwiGLU8 {
    static constexpr bool PERM = true, AFTER_DRAIN = false;
    static constexpr int NST = 8; static constexpr bool LDSOPS = true;
    const float* bgu; unsigned char* ACT; LAS unsigned char* lds;
    __device__ __forceinline__ void prefetch(const Unit& u, int wid, int lane) const {
        const int idx = (wid & 3) * 64 + lane; const float* src = bgu + (size_t)u.e * 4096 + u.pn * HALF + (idx < 128 ? idx : 2048 + idx - 128);
        __builtin_amdgcn_global_load_lds((const unsigned*)src, (LAS unsigned*)(lds + EPI_OFF + wid * 256), 4, 0, 0);
    }
    __device__ __forceinline__ void operator()(const f32x4 (&acc)[2][2][4][2], const Unit& u, int wr, int wc, int fr, int fq) const {
        const int row0 = u.pm * BM + wr * 64 + fr, colA = u.pn * HALF + wc * 32 + 8 * fq;
        const LAS float* bb = (const LAS float*)(lds + EPI_OFF) + wc * 32 + 8 * fq;
        const f32x4 bg0 = *(const LAS f32x4*)(bb), bg1 = *(const LAS f32x4*)(bb + 4), bu0 = *(const LAS f32x4*)(bb + 128), bu1 = *(const LAS f32x4*)(bb + 128 + 4);
#pragma unroll
        for (int ai = 0; ai < 2; ++ai)
#pragma unroll
            for (int m = 0; m < 4; ++m) { const size_t row = (size_t)(row0 + ai * HALF + m * 16);
                f32x4 o[2];
#pragma unroll
                for (int n = 0; n < 2; ++n)
#pragma unroll
                    for (int jp = 0; jp < 2; ++jp) { const f32x4 ag = acc[ai][0][m][n], au = acc[ai][1][m][n], bgv = n ? bg1 : bg0, buv = n ? bu1 : bu0;
                        const f32x2 gt = (f32x2){ag[2 * jp], ag[2 * jp + 1]} * 0.0001220703125f + (f32x2){bgv[2 * jp], bgv[2 * jp + 1]}, up = (f32x2){au[2 * jp], au[2 * jp + 1]} * 0.0001220703125f + (f32x2){buv[2 * jp], buv[2 * jp + 1]};
                        const f32x2 g = {fminf(gt.x, 7.0f), fminf(gt.y, 7.0f)}, uu = {fminf(fmaxf(up.x, -7.0f), 7.0f), fminf(fmaxf(up.y, -7.0f), 7.0f)};
                        const f32x2 z = g * -2.45546695959f;
                        const f32x2 d = (f32x2){__builtin_amdgcn_exp2f(z.x), __builtin_amdgcn_exp2f(z.y)} + 1.0f;
                        const f32x2 r = {__builtin_amdgcn_rcpf(d.x), __builtin_amdgcn_rcpf(d.y)};
                        const f32x2 ov = (uu * 4.0f + 4.0f) * (g * r);
                        o[n][2 * jp] = ov.x; o[n][2 * jp + 1] = ov.y; }
                u32x2 w; w.x = pk4_fp8_nc(o[0][0], o[0][1], o[0][2], o[0][3]); w.y = pk4_fp8_nc(o[1][0], o[1][1], o[1][2], o[1][3]);
                *(u32x2*)(ACT + row * 2048 + colA) = w; }
    }
};
struct EpiDown {
    static constexpr bool PERM = true, AFTER_DRAIN = false;
    static constexpr int NST = 16; static constexpr bool LDSOPS = true;
    const float* bd; const float* roww; bf16_t* YD; float sc; LAS unsigned char* lds;
    __device__ __forceinline__ void prefetch(const Unit& u, int wid, int lane) const {
        const int idx = (wid & 3) * 64 + lane; const float* src = wid < 4 ? bd + (size_t)u.e * 2048 + u.pn * BM + idx : roww + (size_t)u.pm * BM + idx;
        __builtin_amdgcn_global_load_lds((const unsigned*)src, (LAS unsigned*)(lds + EPI_OFF + wid * 256), 4, 0, 0);
    }
    __device__ __forceinline__ void operator()(const f32x4 (&acc)[2][2][4][2], const Unit& u, int wr, int wc, int fr, int fq) const {
        const int row0 = u.pm * BM + wr * 64 + fr, col0 = u.pn * BM + wc * 32 + 8 * fq;
        const LAS float* bb = (const LAS float*)(lds + EPI_OFF) + wc * 32 + 8 * fq; const LAS float* rwp = (const LAS float*)(lds + EPI_OFF) + 256 + wr * 64 + fr;
        f32x4 bv[2][2];
#pragma unroll
        for (int bj = 0; bj < 2; ++bj)
#pragma unroll
            for (int n = 0; n < 2; ++n) bv[bj][n] = *(const LAS f32x4*)(bb + bj * HALF + 4 * n);
        float rwv[2][4];
#pragma unroll
        for (int ai = 0; ai < 2; ++ai)
#pragma unroll
            for (int m = 0; m < 4; ++m) rwv[ai][m] = rwp[ai * HALF + m * 16] * (YD_FP8 ? 64.0f : 1.0f);
#pragma unroll
        for (int ai = 0; ai < 2; ++ai)
#pragma unroll
            for (int m = 0; m < 4; ++m) { const size_t row = (size_t)(row0 + ai * HALF + m * 16); const float rw = rwv[ai][m];
#pragma unroll
                for (int bj = 0; bj < 2; ++bj) { const f32x4 v0 = (acc[ai][bj][m][0] * sc + bv[bj][0]) * rw, v1 = (acc[ai][bj][m][1] * sc + bv[bj][1]) * rw;
#if YD_FP8
                    u32x2 w8; w8.x = pk4_fp8(v0[0], v0[1], v0[2], v0[3]); w8.y = pk4_fp8(v1[0], v1[1], v1[2], v1[3]);
                    *(u32x2*)((unsigned char*)YD + row * 2048 + col0 + bj * HALF) = w8; } }
#else
                    u32x4 w; w.x = pk2(v0[0], v0[1]); w.y = pk2(v0[2], v0[3]); w.z = pk2(v1[0], v1[1]); w.w = pk2(v1[2], v1[3]);
                    *(u32x4*)(YD + row * 2048 + col0 + bj * HALF) = w; } }
#endif
    }
};
struct GroupedOrder {
    int nM, nN, nwg, G, c; const int* blk_e; bool degen = false;
    __device__ void init(int NB, int nN_, int G_, int c_, const int* be) { nM = NB; nN = nN_; nwg = nM * nN; G = G_; c = c_; blk_e = be; }
    __device__ bool next(int i, Unit& u) const {
        const long L = (long)i * G + c; if (L >= nwg) return false;
        int wgid = (int)L; { const int q = nwg / NXCD, r = nwg % NXCD, xcd = wgid % NXCD, off = wgid / NXCD; wgid = (xcd < r ? xcd * (q + 1) : r * (q + 1) + (xcd - r) * q) + off; }
        const int nig = WGM * nN, gid = wgid / nig, fm = gid * WGM, gsz = (nM - fm) < WGM ? (nM - fm) : WGM;
        u.pm = fm + ((wgid % nig) % gsz); u.pn = (wgid % nig) / gsz; if (degen) { u.pm = 0; u.pn = 0; } u.e = __builtin_amdgcn_readfirstlane(blk_e[u.pm]); return true;
    }
    __device__ __forceinline__ void a_ready(const Unit&) const {}
    __device__ __forceinline__ void done(const Unit&) const {}
};
}

__device__ __forceinline__ void tr_item(const float* W, int N, int K, int k0, int n0, bf16* dst, int drow0, LAS float* scr, int lane) {
    const float* src = W + (size_t)k0 * N + n0 + lane;
#pragma unroll
    for (int i = 0; i < 64; ++i) scr[i * 65 + lane] = __builtin_nontemporal_load(src + (size_t)i * N);
    asm volatile("s_waitcnt lgkmcnt(0)" ::: "memory");
    const int c = lane & 7;
#pragma unroll
    for (int p = 0; p < 8; ++p) { const int n = (lane >> 3) + 8 * p; const LAS float* s = scr + (8 * c) * 65 + n;
        u32x4 o; o.x = pk2(s[0 * 65], s[1 * 65]); o.y = pk2(s[2 * 65], s[3 * 65]); o.z = pk2(s[4 * 65], s[5 * 65]); o.w = pk2(s[6 * 65], s[7 * 65]);
        *(u32x4*)(dst + (size_t)(drow0 + n) * K + k0 + 8 * c) = o; }
    asm volatile("s_waitcnt lgkmcnt(0)" ::: "memory");
}
__device__ __forceinline__ void tr_item8(const float* W, int N, int K, int k0, int n0, unsigned char* dst, int drow0, float scale, LAS float* scr, int lane) {
    const float* src = W + (size_t)k0 * N + n0 + lane;
#pragma unroll
    for (int i = 0; i < 64; ++i) scr[i * 65 + lane] = __builtin_nontemporal_load(src + (size_t)i * N);
    asm volatile("s_waitcnt lgkmcnt(0)" ::: "memory");
    const int c = lane & 3;
#pragma unroll
    for (int p = 0; p < 4; ++p) { const int n = (lane >> 2) + 16 * p; const LAS float* s = scr + (16 * c) * 65 + n;
        u32x4 o; o.x = pk4_fp8(s[0 * 65] * scale, s[1 * 65] * scale, s[2 * 65] * scale, s[3 * 65] * scale); o.y = pk4_fp8(s[4 * 65] * scale, s[5 * 65] * scale, s[6 * 65] * scale, s[7 * 65] * scale);
        o.z = pk4_fp8(s[8 * 65] * scale, s[9 * 65] * scale, s[10 * 65] * scale, s[11 * 65] * scale); o.w = pk4_fp8(s[12 * 65] * scale, s[13 * 65] * scale, s[14 * 65] * scale, s[15 * 65] * scale);
        __builtin_nontemporal_store(o, (u32x4*)(dst + (size_t)(drow0 + n) * K + k0 + 16 * c)); }
    asm volatile("s_waitcnt lgkmcnt(0)" ::: "memory");
}
__device__ __forceinline__ void tr_item8b(const float* W, int N, int K, int k0, int n0, unsigned char* dst, int drow0, float scale, LAS unsigned* scr, int lane) {
#pragma unroll
    for (int half = 0; half < 2; ++half) {
        const float* src = W + (size_t)(k0 + 64 * half) * N + n0 + lane;
        float v[64];
#pragma unroll
        for (int r = 0; r < 64; ++r) v[r] = __builtin_nontemporal_load(src + (size_t)r * N);
#pragma unroll
        for (int rp = 0; rp < 32; ++rp) scr[(32 * half + rp) * 65 + lane] = pk2(v[2 * rp], v[2 * rp + 1]);
    }
    asm volatile("s_waitcnt lgkmcnt(0)" ::: "memory");
    const int c = lane & 7;
#pragma unroll
    for (int p = 0; p < 8; ++p) { const int n = (lane >> 3) + 8 * p; const LAS unsigned* s = scr + (8 * c) * 65 + n;
        u32x4 o;
        { const unsigned a = s[0 * 65], b = s[1 * 65]; o.x = pk4_fp8(bflo(a) * scale, bfhi(a) * scale, bflo(b) * scale, bfhi(b) * scale); }
        { const unsigned a = s[2 * 65], b = s[3 * 65]; o.y = pk4_fp8(bflo(a) * scale, bfhi(a) * scale, bflo(b) * scale, bfhi(b) * scale); }
        { const unsigned a = s[4 * 65], b = s[5 * 65]; o.z = pk4_fp8(bflo(a) * scale, bfhi(a) * scale, bflo(b) * scale, bfhi(b) * scale); }
        { const unsigned a = s[6 * 65], b = s[7 * 65]; o.w = pk4_fp8(bflo(a) * scale, bfhi(a) * scale, bflo(b) * scale, bfhi(b) * scale); }
        __builtin_nontemporal_store(o, (u32x4*)(dst + (size_t)(drow0 + n) * K + k0 + 16 * c)); }
    asm volatile("s_waitcnt lgkmcnt(0)" ::: "memory");
}
__device__ __forceinline__ void tr_item8c(const float* W, int N, int K, int k0, int n0, unsigned char* dst, int drow0, float scale, LAS unsigned* scr, int lane, bool tiled = false) {
    const float* src = W + (size_t)k0 * N + n0 + lane;
    float va[64], vb[64];
#pragma unroll
    for (int r = 0; r < 64; ++r) va[r] = __builtin_nontemporal_load(src + (size_t)r * N);
#pragma unroll
    for (int r = 0; r < 64; ++r) vb[r] = __builtin_nontemporal_load(src + (size_t)(64 + r) * N);
#pragma unroll
    for (int rq = 0; rq < 16; ++rq) scr[(0 + rq) * 65 + lane] = pk4_fp8(va[4 * rq] * scale, va[4 * rq + 1] * scale, va[4 * rq + 2] * scale, va[4 * rq + 3] * scale);
#pragma unroll
    for (int r = 0; r < 64; ++r) va[r] = __builtin_nontemporal_load(src + (size_t)(128 + r) * N);
#pragma unroll
    for (int rq = 0; rq < 16; ++rq) scr[(16 + rq) * 65 + lane] = pk4_fp8(vb[4 * rq] * scale, vb[4 * rq + 1] * scale, vb[4 * rq + 2] * scale, vb[4 * rq + 3] * scale);
#pragma unroll
    for (int r = 0; r < 64; ++r) vb[r] = __builtin_nontemporal_load(src + (size_t)(192 + r) * N);
#pragma unroll
    for (int rq = 0; rq < 16; ++rq) scr[(32 + rq) * 65 + lane] = pk4_fp8(va[4 * rq] * scale, va[4 * rq + 1] * scale, va[4 * rq + 2] * scale, va[4 * rq + 3] * scale);
#pragma unroll
    for (int rq = 0; rq < 16; ++rq) scr[(48 + rq) * 65 + lane] = pk4_fp8(vb[4 * rq] * scale, vb[4 * rq + 1] * scale, vb[4 * rq + 2] * scale, vb[4 * rq + 3] * scale);
    asm volatile("s_waitcnt lgkmcnt(0)" ::: "memory");
    const int c = lane & 15;
#pragma unroll
    for (int p = 0; p < 16; ++p) { const int n = (lane >> 4) + 4 * p; const LAS unsigned* s = scr + (4 * c) * 65 + n;
        u32x4 o; o.x = s[0]; o.y = s[65]; o.z = s[130]; o.w = s[195];
        if (tiled) {
            const int drow = drow0 + n, pn = drow >> 8, hf = (drow >> 7) & 1, rb = drow & 127, x = rb & 31, R = (rb & ~31) + ((((x >> 2) & 1) << 4) + ((x >> 3) << 2) + (x & 3));
            const int kbyte = k0 + 16 * c, kt = kbyte >> 7, C = (kbyte & 127) >> 1;
            __builtin_nontemporal_store(o, (u32x4*)(dst + (((size_t)(pn * (K >> 7) + kt) * 2 + hf) * 16384) + pg8::lds_byte(R, C)));
        } else __builtin_nontemporal_store(o, (u32x4*)(dst + (size_t)(drow0 + n) * K + k0 + 16 * c)); }
    asm volatile("s_waitcnt lgkmcnt(0)" ::: "memory");
}
__device__ __forceinline__ void cvt_item(const float* W, int N, int k0, int n0, bf16* dst, int Nd, int nd0, int lane) {
    const float* src = W + (size_t)k0 * N + n0 + 4 * lane;
    f32x4 v[32];
#pragma unroll
    for (int i = 0; i < 32; ++i) v[i] = *(const f32x4*)(src + (size_t)i * N);
#pragma unroll
    for (int kg = 0; kg < 4; ++kg) {
        u32x4* d = (u32x4*)(dst + ((size_t)((k0 >> 3) + kg) * Nd + nd0) * 8);
#pragma unroll
        for (int q = 0; q < 4; ++q) { u32x4 o; o.x = pk2(v[8 * kg + 0][q], v[8 * kg + 1][q]); o.y = pk2(v[8 * kg + 2][q], v[8 * kg + 3][q]); o.z = pk2(v[8 * kg + 4][q], v[8 * kg + 5][q]); o.w = pk2(v[8 * kg + 6][q], v[8 * kg + 7][q]); d[q] = o; }
    }
}
__device__ __forceinline__ void cvt_rm_item(const float* W, int N, int K, int k0, int n0, bf16* dst, int nd0, int lane) {
    const float* src = W + (size_t)k0 * N + n0 + 4 * lane;
    f32x4 v[32];
#pragma unroll
    for (int i = 0; i < 32; ++i) v[i] = *(const f32x4*)(src + (size_t)i * N);
#pragma unroll
    for (int q = 0; q < 4; ++q) { u32x4* d = (u32x4*)(dst + (size_t)(nd0 + q) * K + k0);
#pragma unroll
        for (int kg = 0; kg < 4; ++kg) { u32x4 o; o.x = pk2(v[8 * kg + 0][q], v[8 * kg + 1][q]); o.y = pk2(v[8 * kg + 2][q], v[8 * kg + 3][q]); o.z = pk2(v[8 * kg + 4][q], v[8 * kg + 5][q]); o.w = pk2(v[8 * kg + 6][q], v[8 * kg + 7][q]); d[kg] = o; } }
}
constexpr int MOE_ITEMS = 32 * 64 * 16 + 32 * 64 * 8;
__device__ __forceinline__ void moe_cvt_item(Frame& F, int it) {
    if (it < 32768) { const int e = it >> 10, q = it & 1023, kb = q >> 4, nb = q & 15, n = nb * 256 + 4 * F.lane;
        cvt_rm_item(F.in[22] + (size_t)e * 2048 * 4096, 4096, 2048, kb * 32, nb * 256, WSP(bf16, WS_WGU) + (size_t)e * 4096 * 2048, 256 * ((n & 2047) >> 7) + 128 * (n >> 11) + (n & 127), F.lane); }
    else { const int r = it - 32768, e = r >> 9, q = r & 511, kb = q >> 3, nb = q & 7;
        cvt_rm_item(F.in[24] + (size_t)e * 2048 * 2048, 2048, 2048, kb * 32, nb * 256, WSP(bf16, WS_WDN) + (size_t)e * 2048 * 2048, nb * 256 + 4 * F.lane, F.lane); }
}
constexpr int CVT_ITEMS = 32 * 16 * 128 + 32 * 16 * 64, CVT_NSW = 4;
struct CvtItem { const float* src; unsigned char* dst; int N, k0, drow0; };
__device__ __forceinline__ bool cvt_decode(Frame& F, int it, CvtItem& I) {
    constexpr int S_GU = 32 * 16 * 128, S_DN = 32 * 16 * 64;
    if (it >= S_GU + S_DN) return false;
    if (it < S_GU) { const int e = it >> 11, q = it & 2047, kb = q >> 7, nb = q & 127, n0 = nb * 32;
        I.N = 4096; I.k0 = kb * 128; I.src = F.in[22] + (size_t)e * 2048 * 4096 + (size_t)I.k0 * 4096 + n0; I.dst = WSP(unsigned char, WS_WGU) + (size_t)e * 4096 * 2048;
        I.drow0 = 256 * ((n0 % 2048) / 128) + 128 * (n0 / 2048) + (n0 % 128);
    } else { const int r = it - S_GU, e = r >> 10, q = r & 1023, kb = q >> 6, nb = q & 63, n0 = nb * 32;
        I.N = 2048; I.k0 = kb * 128; I.src = F.in[24] + (size_t)e * 2048 * 2048 + (size_t)I.k0 * 2048 + n0; I.dst = WSP(unsigned char, WS_WDN) + (size_t)e * 2048 * 2048; I.drow0 = n0; }
    return true;
}
__device__ __forceinline__ void moe_cvt_quota(Frame& F, int quota) {
#if MOE_FP8
    if (F.wave >= 4 || quota <= 0) return;
    LAS unsigned char* lbuf = F.lds + F.wave * 32768;
    unsigned* qctr = (unsigned*)(F.ws + WS_CTL) + CW_Q;
    const int lane = F.lane;
#define CVT_TICKET() ((lane == 0) ? (int)__hip_atomic_fetch_add(qctr, 1u, __ATOMIC_RELAXED, __HIP_MEMORY_SCOPE_AGENT) : 0)
#define CVT_DMA(IT, b) do { const char* _s = (const char*)((IT).src) + (size_t)(lane >> 3) * (size_t)((IT).N * 4) + (lane & 7) * 16; _Pragma("unroll") for (int i = 0; i < 16; ++i) \
        __builtin_amdgcn_global_load_lds((const unsigned*)(_s + (size_t)i * (size_t)((IT).N * 32)), (LAS unsigned*)(lbuf + (b) * 16384 + i * 1024), 16, 0, 2); } while (0)
#define CVT_CONSUME(C, b) do { const int c8 = lane & 7; const LAS float* lf = (const LAS float*)(lbuf + (b) * 16384); \
        _Pragma("unroll") for (int q = 0; q < 4; ++q) { const int nn = (lane >> 3) + 8 * q; const LAS float* s = lf + (16 * c8) * 32 + nn; \
            u32x4 o; \
            o.x = pk4_fp8(s[0] * 512.0f, s[32] * 512.0f, s[64] * 512.0f, s[96] * 512.0f); o.y = pk4_fp8(s[128] * 512.0f, s[160] * 512.0f, s[192] * 512.0f, s[224] * 512.0f); \
            o.z = pk4_fp8(s[256] * 512.0f, s[288] * 512.0f, s[320] * 512.0f, s[352] * 512.0f); o.w = pk4_fp8(s[384] * 512.0f, s[416] * 512.0f, s[448] * 512.0f, s[480] * 512.0f); \
            const int drow = (C).drow0 + nn, pn = drow >> 8, hf = (drow >> 7) & 1, rb = drow & 127, x = rb & 31, R = (rb & ~31) + ((((x >> 2) & 1) << 4) + ((x >> 3) << 2) + (x & 3)); \
            __builtin_nontemporal_store(o, (u32x4*)((C).dst + (((size_t)(pn * 16 + ((C).k0 >> 7)) * 2 + hf) * 16384) + pg8::lds_byte(R, 8 * c8))); } \
        asm volatile("s_waitcnt lgkmcnt(0)" ::: "memory"); } while (0)
    CvtItem A, B;
    const int sw = F.bx * 4 + F.wave, SW = F.G * 4;
    int cnt = 0;
    bool va = cvt_decode(F, sw, A); if (!va) return;
    CVT_DMA(A, 0); ++cnt;
    bool vb = false;
    if (cnt < quota) { vb = cvt_decode(F, sw + cnt * SW, B); if (vb) CVT_DMA(B, 1); ++cnt; }
    for (;;) {
        if (vb) asm volatile("s_waitcnt vmcnt(16)" ::: "memory"); else asm volatile("s_waitcnt vmcnt(0)" ::: "memory");
        CVT_CONSUME(A, 0);
        va = false; if (vb && cnt < quota) { va = cvt_decode(F, sw + cnt * SW, A); if (va) CVT_DMA(A, 0); ++cnt; }
        if (!vb) break;
        if (va) asm volatile("s_waitcnt vmcnt(16)" ::: "memory"); else asm volatile("s_waitcnt vmcnt(0)" ::: "memory");
        CVT_CONSUME(B, 1);
        vb = false; if (va && cnt < quota) { vb = cvt_decode(F, sw + cnt * SW, B); if (vb) CVT_DMA(B, 1); ++cnt; }
        if (!va) break;
    }
#undef CVT_CONSUME
    asm volatile("s_waitcnt vmcnt(0)" ::: "memory");
#undef CVT_TICKET
#undef CVT_DMA
#endif
}
__device__ __forceinline__ void p0_prologue(Frame& F) {
    for (int cb = F.bx; cb < 256; cb += F.G) {
        const int col4 = F.lane % 12, rs = F.lane / 12; const bool act = F.lane < 60;
        const float* cvec = F.in[1]; const float* aw = F.in[2] + cb * 48 + col4 * 4;
        f32x4 acc = {0.f, 0.f, 0.f, 0.f};
        const int r0 = F.wave * 256;
#pragma unroll 13
        for (int i = 0; i < 52; ++i) { const bool ok = act && (i * 5 + rs) < 256; const int rr = ok ? r0 + i * 5 + rs : r0;
            const f32x4 w = *(const f32x4*)(aw + (size_t)rr * 12288); const float cv = cvec[rr];
            acc += w * (ok ? cv * sigmoidf_(cv) : 0.f); }
        LAS f32x4* red = (LAS f32x4*)(F.lds + 135168);
        __syncthreads();
        red[F.wave * 64 + F.lane] = acc;
        __syncthreads();
        if (F.tid < 12) { f32x4 s = *(const f32x4*)(F.in[3] + cb * 48 + F.tid * 4);
            for (int w = 0; w < 8; ++w)
#pragma unroll
                for (int q = 0; q < 5; ++q) s += red[w * 64 + q * 12 + F.tid];
            *(f32x4*)(WSP(float, WS_MOD) + cb * 48 + F.tid * 4) = s; }
    }
    LAS float* scr = (LAS float*)(F.lds + F.wave * 16640);
    const int gw = F.bx * NWAVES + F.wave, NGW = F.G * NWAVES;
    constexpr int I_IN = 32 * 144, I_AU = 16 * 32, I_RU = 16 * 32, I_OUT = 32 * 32, I_RG = 16 * 4;
    constexpr int NITEMS = I_IN + I_AU + I_RU + I_OUT + I_RG;
    for (int it = gw; it < NITEMS; it += NGW) {
        int r = it;
        if (r < I_IN) { const int kb = r / 144, nb = r % 144, n0 = nb * 64;
#if INPROJ_FP8
            if (n0 >= 2048 && n0 < 3072) tr_item8(F.in[5], INW, 2048, kb * 64, n0, WSP(unsigned char, WS_WV), n0 - 2048, 512.0f, scr, F.lane);
            else tr_item8(F.in[5], INW, 2048, kb * 64, n0, WSP(unsigned char, WS_WIN), n0 < 2048 ? n0 : n0 - 1024, 512.0f, scr, F.lane);
#else
            if (n0 >= 2048 && n0 < 3072) tr_item(F.in[5], INW, 2048, kb * 64, n0, WSP(bf16, WS_WV), n0 - 2048, scr, F.lane);
            else tr_item(F.in[5], INW, 2048, kb * 64, n0, WSP(bf16, WS_WIN), n0 < 2048 ? n0 : n0 - 1024, scr, F.lane);
#endif
            continue; } r -= I_IN;
        if (r < I_AU) { const int kb = r / 32, nb = r % 32; if (MIX_FP8) tr_item8(F.in[16], 2048, 1024, kb * 64, nb * 64, WSP(unsigned char, WS_WAU), nb * 64, 512.0f, scr, F.lane); else tr_item(F.in[16], 2048, 1024, kb * 64, nb * 64, WSP(bf16, WS_WAU), nb * 64, scr, F.lane); continue; } r -= I_AU;
        if (r < I_RU) { const int kb = r / 32, nb = r % 32; if (MIX_FP8) tr_item8(F.in[17], 2048, 1024, kb * 64, nb * 64, WSP(unsigned char, WS_WRU), nb * 64, 512.0f, scr, F.lane); else tr_item(F.in[17], 2048, 1024, kb * 64, nb * 64, WSP(bf16, WS_WRU), nb * 64, scr, F.lane); continue; } r -= I_RU;
        if (r < I_OUT) { const int kb = r / 32, nb = r % 32; if (MIX_FP8) tr_item8(F.in[18], 2048, 2048, kb * 64, nb * 64, WSP(unsigned char, WS_WOUT), nb * 64, 512.0f, scr, F.lane); else tr_item(F.in[18], 2048, 2048, kb * 64, nb * 64, WSP(bf16, WS_WOUT), nb * 64, scr, F.lane); continue; } r -= I_OUT;
        { const int which = r / 32, q = r % 32, b = q / 4, kb = (q % 4) / 2, nb = q % 2;
          tr_item(F.in[which ? 13 : 11] + (size_t)b * 16384, 128, 128, kb * 64, nb * 64, WSP(bf16, which ? WS_WXT : WS_WAT) + (size_t)b * 16384, nb * 64, scr, F.lane); }
    }
    {
#if MOE_FP8
#else
        constexpr int I_GU = 32 * 32 * 64, I_DN = 32 * 32 * 32;
        for (int it = gw; it < I_GU + I_DN; it += NGW) {
            if (it < I_GU) { const int e = it / 2048, q = it % 2048, kb = q / 64, nb = q % 64, n0 = nb * 64;
                const int drow0 = 256 * ((n0 % 2048) / 128) + 128 * (n0 / 2048) + (n0 % 128);
                tr_item(F.in[22] + (size_t)e * 2048 * 4096, 4096, 2048, kb * 64, n0, WSP(bf16, WS_WGU) + (size_t)e * 4096 * 2048, drow0, scr, F.lane);
            } else { const int r = it - I_GU, e = r / 1024, q = r % 1024, kb = q / 32, nb = q % 32;
                tr_item(F.in[24] + (size_t)e * 2048 * 2048, 2048, 2048, kb * 64, nb * 64, WSP(bf16, WS_WDN) + (size_t)e * 2048 * 2048, nb * 64, scr, F.lane); }
        }
#endif
    }
}

__device__ __forceinline__ void norm_rows(Frame& F, const float* src, const float* gain, int off_sh, int off_sc, bf16* dstb) {
    const float* mod = WSP(float, WS_MOD);
    f32x4 mul[8], add[8];
#pragma unroll
    for (int j = 0; j < 8; ++j) { const int col = 4 * F.lane + 256 * j; const f32x4 g = *(const f32x4*)(gain + col), sc = *(const f32x4*)(mod + off_sc + col); mul[j] = g * (sc + 1.0f); add[j] = *(const f32x4*)(mod + off_sh + col); }
    const int gw = F.bx * NWAVES + F.wave, NGW = F.G * NWAVES;
    for (int m0 = gw; m0 < T_; m0 += 2 * NGW) {
        const int m1 = (m0 + NGW < T_) ? m0 + NGW : m0;
        const f32x4* xr0 = (const f32x4*)(src + (size_t)m0 * D_) + F.lane; const f32x4* xr1 = (const f32x4*)(src + (size_t)m1 * D_) + F.lane;
        f32x4 v0[8], v1[8]; float s0 = 0.f, s1 = 0.f;
#pragma unroll
        for (int j = 0; j < 8; ++j) { v0[j] = xr0[64 * j]; v1[j] = xr1[64 * j]; }
#pragma unroll
        for (int j = 0; j < 8; ++j) { s0 += (v0[j].x * v0[j].x + v0[j].y * v0[j].y) + (v0[j].z * v0[j].z + v0[j].w * v0[j].w); s1 += (v1[j].x * v1[j].x + v1[j].y * v1[j].y) + (v1[j].z * v1[j].z + v1[j].w * v1[j].w); }
        const float r0 = rsqrtf(wave_sum(s0) * (1.0f / D_) + EPS_), r1 = rsqrtf(wave_sum(s1) * (1.0f / D_) + EPS_);
#pragma unroll
        for (int j = 0; j < 8; ++j) { const f32x4 y0 = v0[j] * r0 * mul[j] + add[j], y1 = v1[j] * r1 * mul[j] + add[j];
#if INPROJ_FP8
            ((unsigned*)((unsigned char*)dstb + (size_t)m0 * D_))[F.lane + 64 * j] = pk4_fp8(y0.x * 16.0f, y0.y * 16.0f, y0.z * 16.0f, y0.w * 16.0f);
            ((unsigned*)((unsigned char*)dstb + (size_t)m1 * D_))[F.lane + 64 * j] = pk4_fp8(y1.x * 16.0f, y1.y * 16.0f, y1.z * 16.0f, y1.w * 16.0f);
#else
            u32x2 w; w.x = pk2(y0.x, y0.y); w.y = pk2(y0.z, y0.w); ((u32x2*)(dstb + (size_t)m0 * D_) + F.lane)[64 * j] = w;
            w.x = pk2(y1.x, y1.y); w.y = pk2(y1.z, y1.w); ((u32x2*)(dstb + (size_t)m1 * D_) + F.lane)[64 * j] = w;
#endif
        }
    }
}

__device__ __forceinline__ void p3_rglru_local(Frame& F) {
    LAS float* XCF = (LAS float*)(F.lds);
    LAS bf16* XCB = (LAS bf16*)(F.lds + 32768);
    LAS float* AA = (LAS float*)(F.lds + 50176);
    LAS float* UU = (LAS float*)(F.lds + 82944);
    LAS float* PART = (LAS float*)(F.lds + 115712);
    const bf16* P8 = WSP(bf16, WS_P8);
    const float* convw = F.in[9]; const float* convb = F.in[10];
    const int tid = F.tid, lane = F.lane, wave = F.wave;
    LAS float* CARRY = (LAS float*)(F.lds + 115712 + 4096);
    for (int su = F.bx; su < 256; su += F.G)
    for (int i8 = 0; i8 < 8; ++i8) {
        const int s = (su >> 3) * 8 + i8, b = su & 7, t0 = s * SEG, ch0 = b * 128;
        if (i8 == 0 && tid < 128) { CARRY[tid * 2] = 0.f; CARRY[tid * 2 + 1] = 1.f; }
        {
            const int cg = tid & 15, tt = tid >> 4;
            float cw[4][8], cb[8];
#pragma unroll
            for (int w = 0; w < 4; ++w) { const f32x4 a = *(const f32x4*)(convw + w * RW + ch0 + 8 * cg), c = *(const f32x4*)(convw + w * RW + ch0 + 8 * cg + 4);
                cw[w][0] = a.x; cw[w][1] = a.y; cw[w][2] = a.z; cw[w][3] = a.w; cw[w][4] = c.x; cw[w][5] = c.y; cw[w][6] = c.z; cw[w][7] = c.w; }
            { const f32x4 a = *(const f32x4*)(convb + ch0 + 8 * cg), c = *(const f32x4*)(convb + ch0 + 8 * cg + 4); cb[0] = a.x; cb[1] = a.y; cb[2] = a.z; cb[3] = a.w; cb[4] = c.x; cb[5] = c.y; cb[6] = c.z; cb[7] = c.w; }
#pragma unroll
            for (int pass = 0; pass < 2; ++pass) {
                const int t = tt + 32 * pass, ta = t0 + t;
                float xc[8];
#pragma unroll
                for (int j = 0; j < 8; ++j) xc[j] = cb[j];
#pragma unroll
                for (int w = 0; w < 4; ++w) { const int row = ta - 3 + w;
                    if (row >= 0) { const u32x4 xv = *(const u32x4*)(P8 + (size_t)row * PW + PRX + ch0 + 8 * cg);
                        xc[0] += cw[w][0] * bflo(xv.x); xc[1] += cw[w][1] * bfhi(xv.x); xc[2] += cw[w][2] * bflo(xv.y); xc[3] += cw[w][3] * bfhi(xv.y);
                        xc[4] += cw[w][4] * bflo(xv.z); xc[5] += cw[w][5] * bfhi(xv.z); xc[6] += cw[w][6] * bflo(xv.w); xc[7] += cw[w][7] * bfhi(xv.w); } }
                *(LAS f32x4*)(XCF + t * 128 + 8 * cg) = (f32x4){xc[0], xc[1], xc[2], xc[3]};
                *(LAS f32x4*)(XCF + t * 128 + 8 * cg + 4) = (f32x4){xc[4], xc[5], xc[6], xc[7]};
                u32x4 w4; w4.x = pk2(xc[0], xc[1]); w4.y = pk2(xc[2], xc[3]); w4.z = pk2(xc[4], xc[5]); w4.w = pk2(xc[6], xc[7]);
                *(LAS u32x4*)(XCB + t * 136 + 8 * cg) = w4;
            }
        }
        __syncthreads();
        {
            const int r = lane & 31, h = lane >> 5, tt2 = wave >> 2, jt = wave & 3;
            f32x16 accA, accX;
#pragma unroll
            for (int i = 0; i < 16; ++i) { accA[i] = 0.f; accX[i] = 0.f; }
            const bf16* wa = WSP(bf16, WS_WAT) + (size_t)b * 16384 + (32 * jt + r) * 128 + 8 * h;
            const bf16* wx = WSP(bf16, WS_WXT) + (size_t)b * 16384 + (32 * jt + r) * 128 + 8 * h;
#pragma unroll
            for (int ks = 0; ks < 8; ++ks) {
                const bf16x8 a = *(const LAS bf16x8*)(XCB + (32 * tt2 + r) * 136 + 16 * ks + 8 * h);
                const bf16x8 ba = *(const bf16x8*)(wa + 16 * ks), bx = *(const bf16x8*)(wx + 16 * ks);
                accA = __builtin_amdgcn_mfma_f32_32x32x16_bf16(a, ba, accA, 0, 0, 0);
                accX = __builtin_amdgcn_mfma_f32_32x32x16_bf16(a, bx, accX, 0, 0, 0);
            }
            const int j = 32 * jt + r, ch = ch0 + j;
            const float bav = F.in[12][ch], bxv = F.in[14][ch], lam = F.in[15][ch];
            const float sp = (lam > 15.f) ? __expf(-lam) : log1pf(__expf(-lam));
#pragma unroll
            for (int reg = 0; reg < 16; ++reg) { const int t = 32 * tt2 + crow(reg, h);
                const float rr = sigmoidf_(accA[reg] + bav), ii = sigmoidf_(accX[reg] + bxv);
                const float la = -8.0f * rr * sp, a = __expf(la);
                const float x2 = 2.0f * la, em = (x2 > -0.05f) ? -x2 * (1.0f + 0.5f * x2 * (1.0f + 0.33333334f * x2 * (1.0f + 0.25f * x2))) : 1.0f - a * a;
                const float uu = __builtin_amdgcn_sqrtf(em) * (ii * XCF[t * 128 + j]);
                AA[t * 128 + j] = a; UU[t * 128 + j] = uu; }
        }
        __syncthreads();
        {
            const int j = tid & 127, p = tid >> 7;
            float h = 0.f, ac = 1.f;
#pragma unroll
            for (int i = 0; i < 16; ++i) { const int t = 16 * p + i; const float a = AA[t * 128 + j], uu = UU[t * 128 + j]; h = a * h + uu; ac *= a; UU[t * 128 + j] = h; AA[t * 128 + j] = ac; }
            PART[(p * 128 + j) * 2] = ac; PART[(p * 128 + j) * 2 + 1] = h;
            __syncthreads();
            float c = CARRY[j * 2], ap = CARRY[j * 2 + 1];
            for (int q = 0; q < p; ++q) { const float qa = PART[(q * 128 + j) * 2], qh = PART[(q * 128 + j) * 2 + 1]; c = qa * c + qh; ap *= qa; }
            bf16* HL = WSP(bf16, WS_HL); bf16* AC = WSP(bf16, WS_AC);
            float hl = 0.f, acl = 0.f;
#pragma unroll
            for (int i = 0; i < 16; ++i) { const int t = 16 * p + i; hl = UU[t * 128 + j] + AA[t * 128 + j] * c; acl = AA[t * 128 + j] * ap;
                HL[(size_t)(t0 + t) * RW + ch0 + j] = (bf16)(pk2(hl, 0.f) & 0xffffu); AC[(size_t)(t0 + t) * RW + ch0 + j] = (bf16)(pk2(acl, 0.f) & 0xffffu); }
            __syncthreads();
            if (p == 3) { CARRY[j * 2] = hl; CARRY[j * 2 + 1] = acl; if (i8 == 7) { WSP(float, WS_SEGA)[(s >> 3) * RW + ch0 + j] = acl; WSP(float, WS_SEGH)[(s >> 3) * RW + ch0 + j] = hl; } }
        }
        __syncthreads();
    }
}

__device__ __forceinline__ void p4_rglru_fix(Frame& F) {
    const float* SA = WSP(float, WS_SEGA); const float* SH = WSP(float, WS_SEGH);
    const bf16* HL = WSP(bf16, WS_HL); const bf16* AC = WSP(bf16, WS_AC);
    const bf16* P8 = WSP(bf16, WS_P8); bf16* YB = WSP(bf16, WS_YB);
    const int ch = 2 * F.tid;
    for (int s = F.bx; s < NSEG; s += F.G) {
        f32x2 c = {0.f, 0.f};
        const int S = s >> 3;
        for (int j0 = 0; j0 < S; j0 += 16) {
            f32x2 a[16], hh[16];
#pragma unroll
            for (int q = 0; q < 16; ++q) { const int j = (j0 + q < S) ? j0 + q : 0; a[q] = *(const f32x2*)(SA + j * RW + ch); hh[q] = *(const f32x2*)(SH + j * RW + ch); }
#pragma unroll
            for (int q = 0; q < 16; ++q) if (j0 + q < S) c = a[q] * c + hh[q];
        }
#pragma unroll 16
        for (int t = 0; t < SEG; ++t) { const size_t row = (size_t)(s * SEG + t);
            const unsigned hlw = *(const unsigned*)(HL + row * RW + ch), acw = *(const unsigned*)(AC + row * RW + ch);
            const f32x2 hl = {bflo(hlw), bfhi(hlw)}, ac = {bflo(acw), bfhi(acw)};
            const unsigned g = *(const unsigned*)(P8 + row * PW + PRG + ch);
            const f32x2 hh = hl + ac * c;
#if MIX_FP8
            *(unsigned short*)((unsigned char*)YB + row * AW + ch) = (unsigned short)pk4_fp8(32.0f * hh.x * gelu_tanh(bflo(g)), 32.0f * hh.y * gelu_tanh(bfhi(g)), 0.f, 0.f); }
#else
            *(unsigned*)(YB + row * AW + ch) = pk2(hh.x * gelu_tanh(bflo(g)), hh.y * gelu_tanh(bfhi(g))); }
#endif
    }
}

__device__ __forceinline__ void p3_qkprep(Frame& F) {
    const bf16* P8 = WSP(bf16, WS_P8); bf16* QH = WSP(bf16, WS_QH); bf16* KH = WSP(bf16, WS_KH);
    const int hq = F.lane >> 3, d0 = (F.lane & 7) * 16;
    float gq[16], gk[16];
#pragma unroll
    for (int j = 0; j < 16; ++j) { gq[j] = F.in[6][d0 + j] * (0.08838834764831845f * 1.44269504089f); gk[j] = F.in[7][d0 + j]; }
    const int gw = F.bx * NWAVES + F.wave, NGW = F.G * NWAVES;
    for (int t = gw; t < T_; t += NGW) {
#pragma unroll
        for (int which = 0; which < 2; ++which) {
            const bf16* src = P8 + (size_t)t * PW + (which ? PK : PQ) + hq * HD + d0;
            const u32x4 a = *(const u32x4*)src, b = *(const u32x4*)(src + 8);
            float f[16] = {bflo(a.x), bfhi(a.x), bflo(a.y), bfhi(a.y), bflo(a.z), bfhi(a.z), bflo(a.w), bfhi(a.w), bflo(b.x), bfhi(b.x), bflo(b.y), bfhi(b.y), bflo(b.z), bfhi(b.z), bflo(b.w), bfhi(b.w)};
            float ss = 0.f;
#pragma unroll
            for (int j = 0; j < 16; ++j) ss += f[j] * f[j];
            ss += __shfl_xor(ss, 1); ss += __shfl_xor(ss, 2); ss += __shfl_xor(ss, 4);
            const float rs = rsqrtf(ss * (1.0f / HD) + EPS_);
            u32x4 o0, o1;
            if (which == 0) { o0.x = pk2(f[0] * rs * gq[0], f[1] * rs * gq[1]); o0.y = pk2(f[2] * rs * gq[2], f[3] * rs * gq[3]); o0.z = pk2(f[4] * rs * gq[4], f[5] * rs * gq[5]); o0.w = pk2(f[6] * rs * gq[6], f[7] * rs * gq[7]);
                o1.x = pk2(f[8] * rs * gq[8], f[9] * rs * gq[9]); o1.y = pk2(f[10] * rs * gq[10], f[11] * rs * gq[11]); o1.z = pk2(f[12] * rs * gq[12], f[13] * rs * gq[13]); o1.w = pk2(f[14] * rs * gq[14], f[15] * rs * gq[15]); }
            else { o0.x = pk2(f[0] * rs * gk[0], f[1] * rs * gk[1]); o0.y = pk2(f[2] * rs * gk[2], f[3] * rs * gk[3]); o0.z = pk2(f[4] * rs * gk[4], f[5] * rs * gk[5]); o0.w = pk2(f[6] * rs * gk[6], f[7] * rs * gk[7]);
                o1.x = pk2(f[8] * rs * gk[8], f[9] * rs * gk[9]); o1.y = pk2(f[10] * rs * gk[10], f[11] * rs * gk[11]); o1.z = pk2(f[12] * rs * gk[12], f[13] * rs * gk[13]); o1.w = pk2(f[14] * rs * gk[14], f[15] * rs * gk[15]); }
            bf16* dst = (which ? KH : QH) + ((size_t)hq * T_ + t) * HD + d0;
            *(u32x4*)dst = o0; *(u32x4*)(dst + 8) = o1;
        }
    }
}

__device__ __forceinline__ int pi23(int i) { return (i & ~12) | ((i & 4) << 1) | ((i & 8) >> 1); }
__device__ __forceinline__ void p4_attention(Frame& F) {
    constexpr int ST_BYTES = 32768, TAB_OFF = 3 * ST_BYTES;
    LAS float* TAB = (LAS float*)(F.lds + TAB_OFF);
    const bf16* QH = WSP(bf16, WS_QH); const bf16* KH = WSP(bf16, WS_KH); const bf16* VTB = WSP(bf16, WS_VT); bf16* YA = WSP(bf16, WS_YA);
    const int lane = F.lane, r = lane & 31, hh = lane >> 5, w = F.wave;
#define ATT_ISSUE(kc, stage) do { \
        _Pragma("unroll") for (int _i = 0; _i < 2; ++_i) { const int L = (w * 2 + _i) * 64 + lane; const int key = L >> 4, dch = (L & 15) ^ (key & 15); \
            __builtin_amdgcn_global_load_lds((const unsigned*)(KH + ((size_t)hd * T_ + (size_t)(kc) * 64 + key) * HD + dch * 8), (LAS unsigned*)(F.lds + (stage) * ST_BYTES + (w * 2 + _i) * 1024), 16, 0, 0); } \
        _Pragma("unroll") for (int _i = 0; _i < 2; ++_i) { const int L = (w * 2 + _i) * 64 + lane; const int d = L >> 3, kcn = (L & 7) ^ ((d >> 1) & 7); \
            __builtin_amdgcn_global_load_lds((const unsigned*)(VTB + (((size_t)hd * 256 + (kc)) * 128 + d) * 64 + kcn * 8), (LAS unsigned*)(F.lds + (stage) * ST_BYTES + 16384 + (w * 2 + _i) * 1024), 16, 0, 0); } \
    } while (0)
    for (int u = F.bx; u < 512; u += F.G) {
        const int hd = u & 7, g = u >> 3;
        const int kc_first = (4 * g >= 8) ? 4 * g - 8 : 0, kc_last = 4 * g + 3, nsteps = kc_last - kc_first + 1;
        const int cw = 4 * g + (w >> 1), q0 = cw * 64 + (w & 1) * 32;
        for (int i = F.tid; i < 320; i += NWAVES * 64) TAB[i] = F.in[8][hd * 320 + i] * 1.44269504089f;
        bf16x8 Qf[8];
        { const bf16* qrow = QH + ((size_t)hd * T_ + q0 + r) * HD + 8 * hh;
#pragma unroll
          for (int ks = 0; ks < 8; ++ks) Qf[ks] = *(const bf16x8*)(qrow + 16 * ks); }
        ATT_ISSUE(kc_first, 0);
        ATT_ISSUE((nsteps > 1 ? kc_first + 1 : kc_first), 1);
        f32x16 O[4];
#pragma unroll
        for (int db = 0; db < 4; ++db)
#pragma unroll
            for (int i = 0; i < 16; ++i) O[db][i] = 0.f;
        float mrun = -1e30f, lrun = 0.f;
        for (int t = 0; t < nsteps; ++t) {
            const int kc = kc_first + t, stage = t % 3;
            asm volatile("s_waitcnt vmcnt(4)" ::: "memory");
            asm volatile("s_waitcnt lgkmcnt(0)" ::: "memory");
            __builtin_amdgcn_s_barrier();
            asm volatile("" ::: "memory");
            { const int kn = (t + 2 < nsteps) ? kc + 2 : kc_last; const int st2 = (t + 2) % 3; ATT_ISSUE(kn, st2); }
            if (kc <= cw && kc + 8 >= cw) {
                const LAS unsigned char* Kb = F.lds + stage * ST_BYTES; const LAS unsigned char* Vb = Kb + 16384;
                f32x16 S[2], S1[2];
#pragma unroll
                for (int t2 = 0; t2 < 2; ++t2) {
#pragma unroll
                    for (int i = 0; i < 16; ++i) { S[t2][i] = 0.f; S1[t2][i] = 0.f; } }
#pragma unroll
                for (int ks = 0; ks < 8; ks += 2) {
#pragma unroll
                    for (int t2 = 0; t2 < 2; ++t2) { const int key = 32 * t2 + pi23(r);
                        const bf16x8 kf = *(const LAS bf16x8*)(Kb + (key * 16 + ((2 * ks + hh) ^ (key & 15))) * 16), kg = *(const LAS bf16x8*)(Kb + (key * 16 + ((2 * ks + 2 + hh) ^ (key & 15))) * 16);
                        S[t2] = __builtin_amdgcn_mfma_f32_32x32x16_bf16(kf, Qf[ks], S[t2], 0, 0, 0); S1[t2] = __builtin_amdgcn_mfma_f32_32x32x16_bf16(kg, Qf[ks + 1], S1[t2], 0, 0, 0); } }
                float mt = -1e30f;
#pragma unroll
                for (int t2 = 0; t2 < 2; ++t2) {
                    const int dbase = (q0 + r) - (kc * 64 + 32 * t2 + 8 * hh);
#pragma unroll
                    for (int reg = 0; reg < 16; ++reg) { const int kl = (reg & 3) + 4 * ((reg >> 2) & 1) + 16 * (reg >> 3);
                        int dist = dbase - kl; dist = dist < -63 ? -63 : (dist > 256 ? 256 : dist);
                        S[t2][reg] = (S[t2][reg] + S1[t2][reg]) + TAB[dist + 63]; mt = fmaxf(mt, S[t2][reg]); } }
                mt = fmaxf(mt, __shfl_xor(mt, 32));
                const float mn = fmaxf(mrun, mt), alpha = __builtin_amdgcn_exp2f(mrun - mn); mrun = mn;
                float ps = 0.f;
#pragma unroll
                for (int t2 = 0; t2 < 2; ++t2)
#pragma unroll
                    for (int reg = 0; reg < 16; ++reg) { S[t2][reg] = __builtin_amdgcn_exp2f(S[t2][reg] - mn); ps += S[t2][reg]; }
                lrun = lrun * alpha + ps;
                if (__any(alpha != 1.0f)) {
#pragma unroll
                    for (int db = 0; db < 4; ++db)
#pragma unroll
                        for (int i = 0; i < 16; ++i) O[db][i] *= alpha; }
                bf16x8 Pb[2][2];
#pragma unroll
                for (int t2 = 0; t2 < 2; ++t2)
#pragma unroll
                    for (int s2 = 0; s2 < 2; ++s2) { u32x4 pw; pw.x = pk2(S[t2][8 * s2 + 0], S[t2][8 * s2 + 1]); pw.y = pk2(S[t2][8 * s2 + 2], S[t2][8 * s2 + 3]); pw.z = pk2(S[t2][8 * s2 + 4], S[t2][8 * s2 + 5]); pw.w = pk2(S[t2][8 * s2 + 6], S[t2][8 * s2 + 7]); Pb[t2][s2] = __builtin_bit_cast(bf16x8, pw); }
#pragma unroll
                for (int t2 = 0; t2 < 2; ++t2)
#pragma unroll
                    for (int s2 = 0; s2 < 2; ++s2)
#pragma unroll
                        for (int db = 0; db < 4; ++db) { const int d = 32 * db + r;
                            const bf16x8 vf = *(const LAS bf16x8*)(Vb + (d * 8 + ((4 * t2 + 2 * s2 + hh) ^ ((d >> 1) & 7))) * 16);
                            O[db] = __builtin_amdgcn_mfma_f32_32x32x16_bf16(vf, Pb[t2][s2], O[db], 0, 0, 0); }
            }
        }
        lrun += __shfl_xor(lrun, 32);
        const float inv = (MIX_FP8 ? 32.0f : 1.0f) / lrun;
        bf16* orow = YA + (size_t)(q0 + r) * AW + hd * HD + 4 * hh;
#pragma unroll
        for (int db = 0; db < 4; ++db)
#pragma unroll
            for (int gq = 0; gq < 4; ++gq) {
#if MIX_FP8
                *(unsigned*)((unsigned char*)YA + (size_t)(q0 + r) * AW + hd * HD + 4 * hh + 32 * db + 8 * gq) = pk4_fp8(O[db][4 * gq] * inv, O[db][4 * gq + 1] * inv, O[db][4 * gq + 2] * inv, O[db][4 * gq + 3] * inv);
#else
                u32x2 ow; ow.x = pk2(O[db][4 * gq] * inv, O[db][4 * gq + 1] * inv); ow.y = pk2(O[db][4 * gq + 2] * inv, O[db][4 * gq + 3] * inv);
                *(u32x2*)(orow + 32 * db + 8 * gq) = ow;
#endif
            }
        asm volatile("s_waitcnt vmcnt(0) lgkmcnt(0)" ::: "memory");
        __builtin_amdgcn_s_barrier();
        asm volatile("" ::: "memory");
    }
#undef ATT_ISSUE
}

__device__ __forceinline__ void p7_router(Frame& F) {
    LAS float* PARTL = (LAS float*)(F.lds);
    LAS float* LOG = (LAS float*)(F.lds + 65536);
    LAS float* RSTD = (LAS float*)(F.lds + 65536 + 8448);
    LAS int* hist = (LAS int*)(F.lds + 65536 + 8448 + 256);
    const float* mod = WSP(float, WS_MOD); const float* gain = F.in[19];
    const float* WRT = WSP(float, WS_WRT); const float* RB = WSP(float, WS_RB);
    bf16* XN = WSP(bf16, WS_XN); int* TOPE = WSP(int, WS_TOPE); float* TOPW = WSP(float, WS_TOPW);
    const int r = F.lane & 31, kh = F.lane >> 5;
    { int* ROWTOK = WSP(int, WS_ROWTOK);
      for (int i = F.bx * NWAVES * 64 + F.tid; i < NROWS; i += F.G * NWAVES * 64) ROWTOK[i] = T_;
      if (F.bx == 0) ((unsigned*)(WSP(unsigned char, WS_XN) + (size_t)T_ * WPITCH))[F.tid] = 0u; }
    for (int ck = F.bx; ck < 256; ck += F.G) {
        if (F.tid < 32) hist[F.tid] = 0;
        f32x4 mulv[8], addv[8];
#pragma unroll
        for (int j = 0; j < 8; ++j) { const int col = 4 * F.lane + 256 * j; mulv[j] = *(const f32x4*)(gain + col) * (*(const f32x4*)(mod + 8192 + col) + 1.0f); addv[j] = *(const f32x4*)(mod + 6144 + col); }
        for (int i = 0; i < 8; i += 2) {
            const int m0 = ck * 64 + F.wave * 8 + i, m1 = m0 + 1;
            const f32x4* xr0 = (const f32x4*)(F.out + (size_t)m0 * D_) + F.lane; const f32x4* xr1 = (const f32x4*)(F.out + (size_t)m1 * D_) + F.lane;
            f32x4 v0[8], v1[8]; float s0 = 0.f, s1 = 0.f;
#pragma unroll
            for (int j = 0; j < 8; ++j) { v0[j] = xr0[64 * j]; v1[j] = xr1[64 * j]; }
#pragma unroll
            for (int j = 0; j < 8; ++j) { s0 += (v0[j].x * v0[j].x + v0[j].y * v0[j].y) + (v0[j].z * v0[j].z + v0[j].w * v0[j].w); s1 += (v1[j].x * v1[j].x + v1[j].y * v1[j].y) + (v1[j].z * v1[j].z + v1[j].w * v1[j].w); }
            const float r0 = rsqrtf(wave_sum(s0) * (1.0f / D_) + EPS_), r1 = rsqrtf(wave_sum(s1) * (1.0f / D_) + EPS_);
            if (F.lane == 0) { RSTD[F.wave * 8 + i] = r0; RSTD[F.wave * 8 + i + 1] = r1; }
#pragma unroll
            for (int j = 0; j < 8; ++j) { const f32x4 y0 = v0[j] * r0 * mulv[j] + addv[j], y1 = v1[j] * r1 * mulv[j] + addv[j];
#if MOE_FP8
                ((unsigned*)(WSP(unsigned char, WS_XN) + (size_t)m0 * WPITCH))[F.lane + 64 * j] = pk4_fp8(y0.x * 16.0f, y0.y * 16.0f, y0.z * 16.0f, y0.w * 16.0f);
                ((unsigned*)(WSP(unsigned char, WS_XN) + (size_t)m1 * WPITCH))[F.lane + 64 * j] = pk4_fp8(y1.x * 16.0f, y1.y * 16.0f, y1.z * 16.0f, y1.w * 16.0f);
#else
                u32x2 w; w.x = pk2(y0.x, y0.y); w.y = pk2(y0.z, y0.w); ((u32x2*)(XN + (size_t)m0 * D_) + F.lane)[64 * j] = w;
                w.x = pk2(y1.x, y1.y); w.y = pk2(y1.z, y1.w); ((u32x2*)(XN + (size_t)m1 * D_) + F.lane)[64 * j] = w;
#endif
            }
        }
        {
            f32x16 acc0, acc1;
#pragma unroll
            for (int q = 0; q < 16; ++q) { acc0[q] = 0.f; acc1[q] = 0.f; }
            const float* a0p = F.out + (size_t)(ck * 64 + r) * D_ + F.wave * 256 + 4 * kh;
            const float* a1p = a0p + (size_t)32 * D_;
            const float* bp = WRT + (size_t)r * D_ + F.wave * 256 + 4 * kh;
#pragma unroll 4
            for (int g = 0; g < 32; ++g) {
                const f32x4 a0 = *(const f32x4*)(a0p + 8 * g), a1 = *(const f32x4*)(a1p + 8 * g), b = *(const f32x4*)(bp + 8 * g);
#pragma unroll
                for (int q = 0; q < 4; ++q) { acc0 = __builtin_amdgcn_mfma_f32_32x32x2f32(a0[q], b[q], acc0, 0, 0, 0); acc1 = __builtin_amdgcn_mfma_f32_32x32x2f32(a1[q], b[q], acc1, 0, 0, 0); }
            }
#pragma unroll
            for (int reg = 0; reg < 16; ++reg) { const int tok = crow(reg, kh); PARTL[(F.wave * 64 + tok) * 32 + r] = acc0[reg]; PARTL[(F.wave * 64 + 32 + tok) * 32 + r] = acc1[reg]; }
        }
        __syncthreads();
        {
            const int tok = F.tid >> 3, e4 = (F.tid & 7) * 4;
            f32x4 sacc = {0.f, 0.f, 0.f, 0.f};
#pragma unroll
            for (int w = 0; w < 8; ++w) sacc += *(const LAS f32x4*)(PARTL + (w * 64 + tok) * 32 + e4);
            const f32x4 lg = sacc * RSTD[tok] + *(const f32x4*)(RB + e4);
            LOG[tok * 33 + e4] = lg.x; LOG[tok * 33 + e4 + 1] = lg.y; LOG[tok * 33 + e4 + 2] = lg.z; LOG[tok * 33 + e4 + 3] = lg.w;
        }
        __syncthreads();
        {
            const int tok = F.tid >> 3, sub = F.tid & 7, m = ck * 64 + tok;
            float lg[4];
#pragma unroll
            for (int j = 0; j < 4; ++j) lg[j] = LOG[tok * 33 + sub * 4 + j];
            int ti[4]; float tv[4];
#pragma unroll
            for (int k = 0; k < 4; ++k) { float best = lg[0]; int bi = sub * 4;
#pragma unroll
                for (int j = 1; j < 4; ++j) if (lg[j] > best) { best = lg[j]; bi = sub * 4 + j; }
#pragma unroll
                for (int o = 1; o < 8; o <<= 1) { const float ov = __shfl_xor(best, o); const int oi = __shfl_xor(bi, o); if (ov > best || (ov == best && oi < bi)) { best = ov; bi = oi; } }
                ti[k] = bi; tv[k] = best;
#pragma unroll
                for (int j = 0; j < 4; ++j) if (bi == sub * 4 + j) lg[j] = -3.0e38f; }
            if (sub == 0) {
                const float e1 = __expf(tv[1] - tv[0]), e2 = __expf(tv[2] - tv[0]), e3 = __expf(tv[3] - tv[0]); const float inv = 1.0f / (1.0f + e1 + e2 + e3);
                *(int4*)(TOPE + m * 4) = make_int4(ti[0], ti[1], ti[2], ti[3]); *(f32x4*)(TOPW + m * 4) = (f32x4){inv, e1 * inv, e2 * inv, e3 * inv};
                __hip_atomic_fetch_add(&hist[ti[0]], 1, __ATOMIC_RELAXED, __HIP_MEMORY_SCOPE_WORKGROUP); __hip_atomic_fetch_add(&hist[ti[1]], 1, __ATOMIC_RELAXED, __HIP_MEMORY_SCOPE_WORKGROUP);
                __hip_atomic_fetch_add(&hist[ti[2]], 1, __ATOMIC_RELAXED, __HIP_MEMORY_SCOPE_WORKGROUP); __hip_atomic_fetch_add(&hist[ti[3]], 1, __ATOMIC_RELAXED, __HIP_MEMORY_SCOPE_WORKGROUP); }
        }
        __syncthreads();
        if (F.tid < 32) WSP(int, WS_HIST)[ck * 32 + F.tid] = hist[F.tid];
        __syncthreads();
    }
}

__device__ __forceinline__ void p8_place(Frame& F) {
    LAS int* es = (LAS int*)(F.lds);
    LAS int* dsts = es + 256;
    LAS int* cnt = es + 512;
    LAS int* base = es + 544;
    LAS int* pst = es + 576;
    const int* HIST = WSP(int, WS_HIST); const int* TOPE = WSP(int, WS_TOPE); const float* TOPW = WSP(float, WS_TOPW);
    int* POS = WSP(int, WS_POS); float* ROWW = WSP(float, WS_ROWW); int* PLAN = WSP(int, WS_PLAN);
    const bf16* XN = WSP(bf16, WS_XN); bf16* XB = WSP(bf16, WS_XB);
    for (int ck = F.bx; ck < 256; ck += F.G) {
        { LAS int* ptot = es + 640; LAS int* ppre = es + 1152;
          const int e = F.tid & 31, p = F.tid >> 5; int tot = 0, pre = 0;
#pragma unroll
          for (int q = 0; q < 16; ++q) { const int c2 = p * 16 + q; const int v = HIST[c2 * 32 + e]; tot += v; pre += (c2 < ck) ? v : 0; }
          ptot[p * 32 + e] = tot; ppre[p * 32 + e] = pre;
          __syncthreads();
          if (F.tid < 32) { int t = 0, pr = 0;
#pragma unroll
              for (int q = 0; q < 16; ++q) { t += ptot[q * 32 + F.tid]; pr += ppre[q * 32 + F.tid]; }
              cnt[F.tid] = t; base[F.tid] = pr; } }
        __syncthreads();
        if (F.tid == 0) { int ps = 0; for (int e = 0; e < 32; ++e) { pst[e] = ps; const int nb = (cnt[e] + 255) >> 8;
                if (ck == 0) { PLAN[32 + e] = ps; PLAN[64 + e] = cnt[e]; for (int q = 0; q < nb; ++q) PLAN[128 + (ps >> 8) + q] = e; }
                ps += nb << 8; }
            if (ck == 0) PLAN[0] = ps >> 8; }
        if (F.tid < 256) es[F.tid] = TOPE[ck * 256 + F.tid];
        __syncthreads();
        if (F.tid < 256) { const int e = es[F.tid]; int rank = 0; for (int j = 0; j < F.tid; ++j) rank += (es[j] == e) ? 1 : 0;
            const int dest = pst[e] + base[e] + rank; dsts[F.tid] = dest; POS[ck * 256 + F.tid] = dest; ROWW[dest] = TOPW[ck * 256 + F.tid]; WSP(int, WS_ROWTOK)[dest] = ck * 64 + (F.tid >> 2); }
        __syncthreads();
#if !MOE_FP8
        for (int i = F.wave * 32; i < F.wave * 32 + 32; ++i) { const int tok = ck * 64 + (i >> 2), dest = dsts[i];
#if MOE_FP8
            const u32x4* srow = (const u32x4*)((const unsigned char*)XN + (size_t)tok * D_) + F.lane; u32x4* drow = (u32x4*)((unsigned char*)XB + (size_t)dest * D_) + F.lane;
#pragma unroll
            for (int q = 0; q < 2; ++q) drow[64 * q] = srow[64 * q]; }
#else
            const u32x4* srow = (const u32x4*)(XN + (size_t)tok * D_) + F.lane; u32x4* drow = (u32x4*)(XB + (size_t)dest * D_) + F.lane;
#pragma unroll
            for (int q = 0; q < 4; ++q) drow[64 * q] = srow[64 * q]; }
#endif
#endif
        __syncthreads();
    }
}

__device__ __forceinline__ void p11_combine(Frame& F) {
    const float* g2 = WSP(float, WS_MOD) + 10240; const int* POS = WSP(int, WS_POS); const bf16* YD = WSP(bf16, WS_YD);
    f32x4 gv[8];
#pragma unroll
    for (int j = 0; j < 8; ++j) gv[j] = *(const f32x4*)(g2 + 4 * F.lane + 256 * j) * (YD_FP8 ? 0.015625f : 1.0f);
    const int gw = F.bx * NWAVES + F.wave, NGW = F.G * NWAVES;
    for (int m = gw; m < T_; m += NGW) {
        const int4 ps = *(const int4*)(POS + m * 4);
        f32x4* orow = (f32x4*)(F.out + (size_t)m * D_) + F.lane;
#if YD_FP8
        const unsigned* r0 = (const unsigned*)((const unsigned char*)YD + (size_t)ps.x * D_) + F.lane; const unsigned* r1 = (const unsigned*)((const unsigned char*)YD + (size_t)ps.y * D_) + F.lane;
        const unsigned* r2 = (const unsigned*)((const unsigned char*)YD + (size_t)ps.z * D_) + F.lane; const unsigned* r3 = (const unsigned*)((const unsigned char*)YD + (size_t)ps.w * D_) + F.lane;
#pragma unroll
        for (int j = 0; j < 8; ++j) { const int a = (int)r0[64 * j], b = (int)r1[64 * j], c = (int)r2[64 * j], d = (int)r3[64 * j];
            f32x4 y; y.x = ((__builtin_amdgcn_cvt_f32_fp8(a, 0) + __builtin_amdgcn_cvt_f32_fp8(b, 0)) + __builtin_amdgcn_cvt_f32_fp8(c, 0)) + __builtin_amdgcn_cvt_f32_fp8(d, 0);
            y.y = ((__builtin_amdgcn_cvt_f32_fp8(a, 1) + __builtin_amdgcn_cvt_f32_fp8(b, 1)) + __builtin_amdgcn_cvt_f32_fp8(c, 1)) + __builtin_amdgcn_cvt_f32_fp8(d, 1);
            y.z = ((__builtin_amdgcn_cvt_f32_fp8(a, 2) + __builtin_amdgcn_cvt_f32_fp8(b, 2)) + __builtin_amdgcn_cvt_f32_fp8(c, 2)) + __builtin_amdgcn_cvt_f32_fp8(d, 2);
            y.w = ((__builtin_amdgcn_cvt_f32_fp8(a, 3) + __builtin_amdgcn_cvt_f32_fp8(b, 3)) + __builtin_amdgcn_cvt_f32_fp8(c, 3)) + __builtin_amdgcn_cvt_f32_fp8(d, 3);
            orow[64 * j] = orow[64 * j] + gv[j] * y; }
#else
        const u32x2* r0 = (const u32x2*)(YD + (size_t)ps.x * D_) + F.lane; const u32x2* r1 = (const u32x2*)(YD + (size_t)ps.y * D_) + F.lane;
        const u32x2* r2 = (const u32x2*)(YD + (size_t)ps.z * D_) + F.lane; const u32x2* r3 = (const u32x2*)(YD + (size_t)ps.w * D_) + F.lane;
#pragma unroll
        for (int j = 0; j < 8; ++j) { const u32x2 a = r0[64 * j], b = r1[64 * j], c = r2[64 * j], d = r3[64 * j];
            f32x4 y; y.x = ((bflo(a.x) + bflo(b.x)) + bflo(c.x)) + bflo(d.x); y.y = ((bfhi(a.x) + bfhi(b.x)) + bfhi(c.x)) + bfhi(d.x);
            y.z = ((bflo(a.y) + bflo(b.y)) + bflo(c.y)) + bflo(d.y); y.w = ((bfhi(a.y) + bfhi(b.y)) + bfhi(c.y)) + bfhi(d.y);
            orow[64 * j] = orow[64 * j] + gv[j] * y; }
#endif
    }
}

struct Args { const float* in[26]; float* out; unsigned char* ws; int ph_lo, ph_hi; };
__global__ void __launch_bounds__(NWAVES * 64, 2) skel_fwd(Args args) {
    extern __shared__ __attribute__((aligned(16))) unsigned char lds[];
    Frame F;
    F.lds = (LAS unsigned char*)lds;
    F.tid = threadIdx.x; F.lane = F.tid & 63; F.wave = __builtin_amdgcn_readfirstlane(F.tid >> 6);
    F.G = gridDim.x; F.bx = blockIdx.x;
#pragma unroll
    for (int i = 0; i < 26; ++i) F.in[i] = args.in[i];
    F.out = args.out; F.ws = args.ws;
    volatile LAS unsigned* MISC = (volatile LAS unsigned*)(F.lds + MISC_OFF);
    if (F.tid < 64) MISC[F.tid] = 0u;
    __syncthreads();
    XcdBarrier bar; bar.bar = (unsigned*)(F.ws + WS_CTL) + CW_BAR; bar.x = 0; bar.st = nullptr;
    if (MK_ONE_LAUNCH) bar = xcd_barrier_post((unsigned*)(F.ws + WS_CTL) + CW_BAR, MISC + 8);
    F.vbx = F.bx;
    if (MK_ONE_LAUNCH) { if (F.tid == 0) MISC[16] = __hip_atomic_fetch_add((unsigned*)(F.ws + WS_CTL) + CW_RANK + 64 * bar.x, 1u, __ATOMIC_RELAXED, __HIP_MEMORY_SCOPE_AGENT); __syncthreads(); }
    const int lo = args.ph_lo, hi = args.ph_hi;
#define RS_ARGS(k, rounds) ((ROUND_SYNC && MK_ONE_LAUNCH) ? (unsigned*)(F.ws + WS_CTL) + CW_RS + 1024 * (k) + 64 * bar.x : (unsigned*)nullptr), (unsigned)MISC[8], (rounds)
#ifndef PH_MASK
#define PH_MASK 0xfff
#endif
#define IN(k) (((PH_MASK >> (k)) & 1) && lo <= (k) && (k) < hi)
#ifndef REP_MASK
#define REP_MASK 0
#endif
#define REPS(k) for (int rep_ = 0; rep_ < 1 + ((REP_MASK >> (k)) & 1); ++rep_)
#define REPBAR() do { if (rep_) xcd_barrier(bar); } while (0)
#define SEAM(k) do { if (MK_ONE_LAUNCH && IN(k) && IN((k) + 1)) xcd_barrier(bar); } while (0)
    using namespace pg8;
    if (IN(0)) REPS(0) { REPBAR(); p0_prologue(F); } SEAM(0);
#ifndef REAL_XCC
#define REAL_XCC 1
#endif
    if (MK_ONE_LAUNCH && REAL_XCC && lo == 0 && hi > 1) {
        bool ok = (F.G == 256);
        for (int j = 0; j < 16; ++j) { const unsigned cj = __hip_atomic_load(bar.bar + XB_XCNT(j), __ATOMIC_RELAXED, __HIP_MEMORY_SCOPE_AGENT); ok = ok && (cj == (j < 8 ? 32u : 0u)); }
        const unsigned rk = MISC[16];
        if (ok && rk < 32u && bar.x < 8u) F.vbx = (int)(rk * 8u + bar.x);
    }
    if (IN(1)) REPS(1) { REPBAR(); norm_rows(F, F.in[0], F.in[4], 0, 2048, WSP(bf16, WS_XN));
        const int gw = F.bx * NWAVES + F.wave;
        if (gw < NE) { const float* mod = WSP(float, WS_MOD); float bs = 0.f;
            for (int k = F.lane; k < D_; k += 64) { const float w = F.in[20][(size_t)k * NE + gw]; WSP(float, WS_WRT)[(size_t)gw * D_ + k] = w * (F.in[19][k] * (1.0f + mod[8192 + k])); bs += mod[6144 + k] * w; }
            bs = wave_sum(bs); if (F.lane == 0) WSP(float, WS_RB)[gw] = bs + F.in[21][gw]; }
    } SEAM(1);
    if (IN(2)) REPS(2) { REPBAR();
        const int cgrp = (F.bx >> 3) & 1;
#if CVT_HOST == 2
        if (cgrp == 0) { moe_cvt_quota(F, (CVT_ITEMS + F.G * CVT_NSW - 1) / (F.G * CVT_NSW)); __syncthreads(); }
#endif
#if INPROJ_FP8
        { Gemm g{WSP(bf16, WS_XN), WSP(bf16, WS_WIN), T_, PW, D_ / 2, 0, 0, RS_ARGS(0, (T_ / 256) * (PW / 256) / F.G), 0, 0}; StaticOrder S; S.init(T_, PW, F.G, F.vbx); EpiProj E{WSP(bf16, WS_P8), PW, 0.0001220703125f, WSP(bf16, WS_QH), WSP(bf16, WS_KH), F.in[6], F.in[7], (LAS float*)(F.lds + ROWTAB_OFF)};
          gemm_phase<EpiProj, StaticOrder, true, true, false, true>(F.lds, g, S, E); }
        { Gemm g{WSP(bf16, WS_WV), WSP(bf16, WS_XN), AW, T_, D_ / 2, 0, 0, nullptr, 0u, 0, 0, 0}; StaticOrder S; S.init(AW, T_, F.G, F.vbx); EpiVtb E{WSP(bf16, WS_VT), 0.0001220703125f};
          gemm_phase<EpiVtb, StaticOrder, true, true, false, true>(F.lds, g, S, E); }
#if CVT_HOST == 2
        if (cgrp == 1) { __syncthreads(); moe_cvt_quota(F, (CVT_ITEMS + F.G * CVT_NSW - 1) / (F.G * CVT_NSW)); }
#endif
#else
        { Gemm g{WSP(bf16, WS_XN), WSP(bf16, WS_WIN), T_, PW, D_, 0, 0, nullptr, 0u, 0, 0, 0}; StaticOrder S; S.init(T_, PW, F.G, F.vbx); EpiStoreBf16 E{WSP(bf16, WS_P8), PW, 1.0f};
          gemm_phase<EpiStoreBf16, StaticOrder, true, true>(F.lds, g, S, E); }
        { Gemm g{WSP(bf16, WS_WV), WSP(bf16, WS_XN), AW, T_, D_, 0, 0, nullptr, 0u, 0, 0, 0}; StaticOrder S; S.init(AW, T_, F.G, F.vbx); EpiVtb E{WSP(bf16, WS_VT), 1.0f};
          gemm_phase<EpiVtb, StaticOrder, true, true>(F.lds, g, S, E); }
#endif
    } SEAM(2);
    if (IN(3)) REPS(3) { REPBAR(); if (!INPROJ_FP8) p3_qkprep(F); p3_rglru_local(F); } SEAM(3);
    if (IN(4)) REPS(4) { REPBAR();
#ifndef PROBE_P4
#define PROBE_P4 0
#endif
#if CVT_HOST == 4
        if (((F.bx >> 3) & 1) == 0) { moe_cvt_quota(F, (CVT_ITEMS + F.G * CVT_NSW - 1) / (F.G * CVT_NSW)); __syncthreads(); }
#endif
        for (int ps = 0; ps < 2; ++ps) { if ((ps ^ ((F.bx >> 3) & 1)) == 0) { if (!(PROBE_P4 == 2 && rep_ == 0)) p4_rglru_fix(F); } else { if (!(PROBE_P4 == 1 && rep_ == 0)) p4_attention(F); } __syncthreads(); }
#if CVT_HOST == 4
        if (((F.bx >> 3) & 1) == 1) { moe_cvt_quota(F, (CVT_ITEMS + F.G * CVT_NSW - 1) / (F.G * CVT_NSW)); }
#endif
    } SEAM(4);
    if (IN(5)) REPS(5) { REPBAR();
#if MIX_FP8
        { Gemm g{WSP(bf16, WS_YA), WSP(bf16, WS_WAU), T_, D_, AW / 2, 0, 0, nullptr, 0u, 0, 0, 0}; StaticOrder S; S.init(T_, D_, F.G, F.vbx); EpiMerge1 E{WSP(float, WS_T1), WSP(bf16, WS_P8) + PGA, PW, 0.00006103515625f};
          gemm_phase<EpiMerge1, StaticOrder, true, true, false, true>(F.lds, g, S, E); }
        { Gemm g{WSP(bf16, WS_YB), WSP(bf16, WS_WRU), T_, D_, RW / 2, 0, 0, nullptr, 0u, 0, 0, 0}; StaticOrder S; S.init(T_, D_, F.G, F.vbx); EpiMerge2 E{WSP(float, WS_T1), WSP(bf16, WS_P8) + PGB, PW, WSP(bf16, WS_MG), 0.00006103515625f};
          gemm_phase<EpiMerge2, StaticOrder, true, true, false, true>(F.lds, g, S, E); }
#else
        { Gemm g{WSP(bf16, WS_YA), WSP(bf16, WS_WAU), T_, D_, AW, 0, 0, nullptr, 0u, 0, 0, 0}; StaticOrder S; S.init(T_, D_, F.G, F.vbx); EpiMerge1 E{WSP(float, WS_T1), WSP(bf16, WS_P8) + PGA, PW, 1.0f};
          gemm_phase<EpiMerge1, StaticOrder, true, true>(F.lds, g, S, E); }
        { Gemm g{WSP(bf16, WS_YB), WSP(bf16, WS_WRU), T_, D_, RW, 0, 0, nullptr, 0u, 0, 0, 0}; StaticOrder S; S.init(T_, D_, F.G, F.vbx); EpiMerge2 E{WSP(float, WS_T1), WSP(bf16, WS_P8) + PGB, PW, WSP(bf16, WS_MG), 1.0f};
          gemm_phase<EpiMerge2, StaticOrder, true, true>(F.lds, g, S, E); }
#endif
    } SEAM(5);
#if MIX_FP8
    if (IN(6)) REPS(6) { REPBAR(); Gemm g{WSP(bf16, WS_MG), WSP(bf16, WS_WOUT), T_, D_, D_ / 2, 0, 0, nullptr, 0u, 0, 0, 0}; StaticOrder S; S.init(T_, D_, F.G, F.vbx); EpiOut E{F.in[0], WSP(float, WS_MOD) + 4096, F.out, 0.000030517578125f};
        gemm_phase<EpiOut, StaticOrder, true, true, false, true>(F.lds, g, S, E); } SEAM(6);
#else
    if (IN(6)) REPS(6) { REPBAR(); Gemm g{WSP(bf16, WS_MG), WSP(bf16, WS_WOUT), T_, D_, D_, 0, 0, nullptr, 0u, 0, 0, 0}; StaticOrder S; S.init(T_, D_, F.G, F.vbx); EpiOut E{F.in[0], WSP(float, WS_MOD) + 4096, F.out, 1.0f};
        gemm_phase<EpiOut, StaticOrder, true, true>(F.lds, g, S, E); } SEAM(6);
#endif
    if (IN(7)) REPS(7) { REPBAR(); p7_router(F); } SEAM(7);
    if (IN(8)) REPS(8) { REPBAR(); p8_place(F); } SEAM(8);
    if (IN(9)) REPS(9) { REPBAR(); const int* PLAN = WSP(int, WS_PLAN); const int NB = __builtin_amdgcn_readfirstlane(PLAN[0]);
        GroupedOrder S; S.init(NB, 16, F.G, F.vbx, PLAN + 128);
#ifndef PROBE_DEGEN
#define PROBE_DEGEN 0
#endif
        S.degen = PROBE_DEGEN && rep_ == 0 && args.ph_hi == N_PHASES;
#if MOE_FP8
        { const int* ROWTOK = WSP(const int, WS_ROWTOK); LAS int* rowtab = (LAS int*)(F.lds + ROWTAB_OFF);
          for (int i = 0; i < 20; ++i) { Unit u; if (!S.next(i, u)) break; if (F.tid < 256) rowtab[i * 256 + F.tid] = ROWTOK[u.pm * 256 + F.tid]; }
          __syncthreads(); }
        Gemm g{WSP(bf16, WS_XN), WSP(bf16, WS_WGU), NB * 256, 4096, D_ / 2, (size_t)4096 * 2048, ROWTAB_OFF, RS_ARGS(1, NB * 16 / F.G), WPITCH, 0}; EpiSwiGLU8 E{F.in[23], WSP(unsigned char, WS_ACT), F.lds};
        gemm_phase<EpiSwiGLU8, GroupedOrder, true, true, true, true, true>(F.lds, g, S, E);
#else
        Gemm g{WSP(bf16, WS_XB), WSP(bf16, WS_WGU), NB * 256, 4096, D_, (size_t)4096 * 2048 * 2, 0, nullptr, 0u, 0, 0, 0}; EpiSwiGLU E{F.in[23], WSP(bf16, WS_ACT)};
        gemm_phase<EpiSwiGLU, GroupedOrder, true, true>(F.lds, g, S, E);
#endif
    } SEAM(9);
    if (IN(10)) REPS(10) { REPBAR(); const int* PLAN = WSP(int, WS_PLAN); const int NB = __builtin_amdgcn_readfirstlane(PLAN[0]);
        GroupedOrder S; S.init(NB, 8, F.G, F.vbx, PLAN + 128);
#if MOE_FP8
        Gemm g{WSP(bf16, WS_ACT), WSP(bf16, WS_WDN), NB * 256, 2048, DFF / 2, (size_t)2048 * 2048, 0, RS_ARGS(2, NB * 8 / F.G), 0, 0}; EpiDown E{F.in[25], WSP(float, WS_ROWW), WSP(bf16, WS_YD), 0.00048828125f, F.lds};
        gemm_phase<EpiDown, GroupedOrder, true, true, true, true>(F.lds, g, S, E);
#else
        Gemm g{WSP(bf16, WS_ACT), WSP(bf16, WS_WDN), NB * 256, 2048, DFF, (size_t)2048 * 2048 * 2, 0, nullptr, 0u, 0, 0, 0}; EpiDown E{F.in[25], WSP(float, WS_ROWW), WSP(bf16, WS_YD), 1.0f, F.lds};
        gemm_phase<EpiDown, GroupedOrder, true, true>(F.lds, g, S, E);
#endif
    } SEAM(10);
    if (IN(11)) REPS(11) { REPBAR(); p11_combine(F); }
#undef IN
#undef SEAM
}

extern "C" void kernel_launch(void* const* d_in, const int* in_sizes, int n_in, void* d_out, int out_size, void* d_ws, size_t ws_size, hipStream_t stream) {
    static int grid = 0;
    if (grid == 0) {
        if (n_in != 26 || out_size != T_ * D_ || ws_size < WS_END) { fprintf(stderr, "kernel_launch: unexpected shapes (n_in %d, out %d, ws %zu)\n", n_in, out_size, ws_size); grid = -1; return; }
        int dev = 0, cus = 0, per_cu = 0;
        if (hipGetDevice(&dev) != hipSuccess || hipDeviceGetAttribute(&cus, hipDeviceAttributeMultiprocessorCount, dev) != hipSuccess) { grid = -1; return; }
        if (hipFuncSetAttribute((const void*)skel_fwd, hipFuncAttributeMaxDynamicSharedMemorySize, LDS_BYTES) != hipSuccess) { fprintf(stderr, "kernel_launch: hipFuncSetAttribute failed\n"); grid = -1; return; }
        if (hipOccupancyMaxActiveBlocksPerMultiprocessor(&per_cu, (const void*)skel_fwd, NWAVES * 64, LDS_BYTES) != hipSuccess || per_cu < 1) fprintf(stderr, "kernel_launch: occupancy query reports %d\n", per_cu);
        (void)hipGetLastError();
        grid = cus;
    }
    if (grid < 0) return;
    if (hipMemsetAsync((char*)d_ws + WS_CTL, 0, CTL_ZERO_BYTES, stream) != hipSuccess) return;
    Args a{};
    for (int i = 0; i < 26; ++i) a.in[i] = (const float*)d_in[i];
    a.out = (float*)d_out; a.ws = (unsigned char*)d_ws;
    if (MK_ONE_LAUNCH) { a.ph_lo = 0; a.ph_hi = N_PHASES; hipLaunchKernelGGL(skel_fwd, dim3(grid), dim3(NWAVES * 64), LDS_BYTES, stream, a); }
    else for (int p = 0; p < N_PHASES; ++p) { a.ph_lo = p; a.ph_hi = p + 1; hipLaunchKernelGGL(skel_fwd, dim3(grid), dim3(NWAVES * 64), LDS_BYTES, stream, a); }
}
```

```cpp
#define LAS __attribute__((address_space(3)))
#include <hip/hip_runtime.h>
#include <cstdio>
#include <cstdint>
namespace pg8 {
#define PG8_LAS __attribute__((address_space(3)))
typedef unsigned short bf16_t;
typedef short bf16x8 __attribute__((ext_vector_type(8)));
typedef float f32x4 __attribute__((ext_vector_type(4)));
typedef unsigned u32x4 __attribute__((ext_vector_type(4)));
typedef int v8i32 __attribute__((ext_vector_type(8)));
typedef short s16x16 __attribute__((ext_vector_type(16)));
constexpr int BM = 256, BK = 64, HALF = 128, HTB = HALF * BK * 2  , STAGE_BYTES = 8 * HTB, NXCD = 8, WGM = 4;

__host__ __device__ __forceinline__ int lds_byte(int r, int c) { const int st = (r >> 4) * 2 + (c >> 5), rr = r & 15, cc = c & 31, ob = rr * 64 + cc * 2; return st * 1024 + (ob ^ (((ob >> 9) & 1) << 5)); }
__host__ __device__ __forceinline__ void stage_rc(int b, int& R, int& C) { const int st = b / 1024, sb = b % 1024, swz = sb ^ (((sb >> 9) & 1) << 5); R = (st >> 1) * 16 + swz / 64; C = (st & 1) * 32 + (swz % 64) / 2; }
__host__ __device__ __forceinline__ int perm32(int rho) { const int n = rho >> 4, i = rho & 15; return 8 * (i >> 2) + 4 * n + (i & 3); }

struct Unit { int pm, pn, e; };
struct Gemm { const bf16_t* A; const bf16_t* Bt; int M, N, K; size_t estride; int rowtab; unsigned* rs_cnt; unsigned rs_n; int rs_rounds; int lda, ldb; };

struct StaticOrder {
    int nM, nN, nwg, G, c;
    __host__ __device__ void init(int M, int N, int G_, int c_) { nM = M / BM; nN = N / BM; nwg = nM * nN; G = G_; c = c_; }
    __host__ __device__ bool next(int i, Unit& u) const {
        const long L = (long)i * G + c; if (L >= nwg) return false;
        int wgid = (int)L; { const int q = nwg / NXCD, r = nwg % NXCD, xcd = wgid % NXCD, off = wgid / NXCD; wgid = (xcd < r ? xcd * (q + 1) : r * (q + 1) + (xcd - r) * q) + off; }
        const int nig = WGM * nN, gid = wgid / nig, fm = gid * WGM, gsz = (nM - fm) < WGM ? (nM - fm) : WGM;
        u.pm = fm + ((wgid % nig) % gsz); u.pn = (wgid % nig) / gsz; u.e = 0; return true;
    }
    __device__ __forceinline__ void a_ready(const Unit&) const {}
    __device__ __forceinline__ void done(const Unit&) const {}
};

__device__ __forceinline__ unsigned cvt_pk_bf16(float lo, float hi) { unsigned r; asm volatile("v_cvt_pk_bf16_f32 %0, %1, %2" : "=v"(r) : "v"(lo), "v"(hi)); return r; }
typedef float f32x2 __attribute__((ext_vector_type(2)));
template <class Epi, class Sched, bool ALIGN_EPI = false, bool SP2 = false, bool BBLK = false, bool F8 = false, bool GATHER = false>
__device__ __forceinline__ void gemm_phase(PG8_LAS unsigned char* lds, const Gemm g, const Sched& S, const Epi& E) {
    const int tid = threadIdx.x, wid = __builtin_amdgcn_readfirstlane(tid >> 6), lane = tid & 63, wr = wid >> 2, wc = wid & 3, fr = lane & 15, fq = lane >> 4;
    const int K = g.K, nt = K / BK;
    const int lda = g.lda ? g.lda : K * 2, ldb = g.ldb ? g.ldb : K * 2;
    unsigned voffA[2], voffB[2]; int Rst[2]; unsigned Cst[2];
#pragma unroll
    for (int i = 0; i < 2; ++i) { int R, C; stage_rc(tid * 16 + i * 8192, R, C); const int Rb = Epi::PERM ? ((R & ~31) + perm32(R & 31)) : R;
        Rst[i] = R; Cst[i] = (unsigned)C * 2u; voffA[i] = (unsigned)(R * lda) + (unsigned)C * 2u; voffB[i] = BBLK ? (unsigned)(tid * 16 + i * 8192) : (unsigned)(Rb * ldb) + (unsigned)C * 2u; }
    const size_t kstep = (size_t)(BK * 2);
    const size_t hstep = (size_t)HALF * lda;
    const size_t kstepB = BBLK ? (size_t)32768 : kstep, hstepB = BBLK ? (size_t)16384 : (size_t)HALF * ldb, tstepB = BBLK ? (size_t)nt * 32768 : 2 * hstepB;
    const size_t tstep = 2 * hstep;
    const unsigned ldsw = (unsigned)wid * 1024u;
    const int aoff = lds_byte(wr * 64 + fr, fq * 8), boff = lds_byte(wc * 32 + fr, fq * 8);
#define PG8_SA(b, h) (((b) * 2 + (h)) * HTB)
#define PG8_SB(b, h) ((4 + (b) * 2 + (h)) * HTB)
#define PG8_STAGE(bufoff, gbase, voff) do { _Pragma("unroll") for (int _i = 0; _i < 2; ++_i) \
        __builtin_amdgcn_global_load_lds((const unsigned*)((const char*)(gbase) + (voff)[_i]), (PG8_LAS unsigned*)(lds + (bufoff) + ldsw + _i * 8192), 16, 0, 0); } while (0)
#define PG8_STAGEA(bufoff, gbase, h, usen) do { if constexpr (GATHER) { _Pragma("unroll") for (int _i = 0; _i < 2; ++_i) { const unsigned _v = (usen) ? nvA[h][_i] : vA[h][_i]; \
        __builtin_amdgcn_global_load_lds((const unsigned*)((const char*)(gbase) + _v), (PG8_LAS unsigned*)(lds + (bufoff) + ldsw + _i * 8192), 16, 0, 0); } } \
    else { PG8_STAGE(bufoff, (gbase) + ((h) ? hstep : 0), voffA); } } while (0)
#define PG8_ROWV(dst, uidx) do { _Pragma("unroll") for (int _h = 0; _h < 2; ++_h) _Pragma("unroll") for (int _i = 0; _i < 2; ++_i) \
        dst[_h][_i] = (unsigned)(*(const PG8_LAS int*)(lds + g.rowtab + ((uidx) * 256 + _h * 128 + Rst[_i]) * 4)) * (unsigned)lda + Cst[_i]; } while (0)
#define PG8_CAT16(lo, hi) __builtin_shufflevector(lo, hi, 0, 1, 2, 3, 4, 5, 6, 7, 8, 9, 10, 11, 12, 13, 14, 15)
#define PG8_LDA(dst, b, h) do { if constexpr (F8) { _Pragma("unroll") for (int m = 0; m < 4; ++m) { const bf16x8 _lo = *(const PG8_LAS bf16x8*)(lds + PG8_SA(b, h) + aoff + m * 2048), _hi = *(const PG8_LAS bf16x8*)(lds + PG8_SA(b, h) + aoff + m * 2048 + 1024); dst##x[m] = PG8_CAT16(_lo, _hi); } } \
        else { _Pragma("unroll") for (int m = 0; m < 4; ++m) _Pragma("unroll") for (int k = 0; k < 2; ++k) dst[m][k] = *(const PG8_LAS bf16x8*)(lds + PG8_SA(b, h) + aoff + m * 2048 + k * 1024); } } while (0)
#define PG8_LDB(dst, b, h) do { if constexpr (F8) { _Pragma("unroll") for (int n = 0; n < 2; ++n) { const bf16x8 _lo = *(const PG8_LAS bf16x8*)(lds + PG8_SB(b, h) + boff + n * 2048), _hi = *(const PG8_LAS bf16x8*)(lds + PG8_SB(b, h) + boff + n * 2048 + 1024); dst##x[n] = PG8_CAT16(_lo, _hi); } } \
        else { _Pragma("unroll") for (int n = 0; n < 2; ++n) _Pragma("unroll") for (int k = 0; k < 2; ++k) dst[n][k] = *(const PG8_LAS bf16x8*)(lds + PG8_SB(b, h) + boff + n * 2048 + k * 1024); } } while (0)
#define PG8_MMA(ai, bj, At, Bt) do { __builtin_amdgcn_s_setprio(1); if constexpr (F8) { \
        _Pragma("unroll") for (int m = 0; m < 4; ++m) _Pragma("unroll") for (int n = 0; n < 2; ++n) \
            asm volatile("v_mfma_scale_f32_16x16x128_f8f6f4 %0, %1, %2, %0, %3, %3 op_sel_hi:[0,0,0]" : "+v"(acc[ai][bj][m][n]) : "v"(Bt##x[n]), "v"(At##x[m]), "v"(f8one)); \
        } else { _Pragma("unroll") for (int m = 0; m < 4; ++m) _Pragma("unroll") for (int n = 0; n < 2; ++n) _Pragma("unroll") for (int k = 0; k < 2; ++k) \
        acc[ai][bj][m][n] = __builtin_amdgcn_mfma_f32_16x16x32_bf16(Bt[n][k], At[m][k], acc[ai][bj][m][n], 0, 0, 0); } __builtin_amdgcn_s_setprio(0); } while (0)
#define PG8_MMAZ(ai, bj, At, Bt) do { __builtin_amdgcn_s_setprio(1); \
        _Pragma("unroll") for (int m = 0; m < 4; ++m) _Pragma("unroll") for (int n = 0; n < 2; ++n) \
            asm volatile("v_mfma_scale_f32_16x16x128_f8f6f4 %0, %1, %2, 0, %3, %3 op_sel_hi:[0,0,0]" : "=&v"(acc[ai][bj][m][n]) : "v"(Bt##x[n]), "v"(At##x[m]), "v"(f8one)); \
        __builtin_amdgcn_s_setprio(0); } while (0)
#define PG8_MMA0(ai, bj, At, Bt) do { if constexpr (F8 && SP2) { if (t == 0) PG8_MMAZ(ai, bj, At, Bt); else PG8_MMA(ai, bj, At, Bt); } else PG8_MMA(ai, bj, At, Bt); } while (0)
#define PG8_WAIT_V(n) asm volatile("s_waitcnt vmcnt(" #n ")" ::: "memory")
#define PG8_WAIT_VS() do { if constexpr (Epi::NST > 0) { if (wsel == 1) asm volatile("s_waitcnt vmcnt(%0)" :: "n"(8 + Epi::NST) : "memory"); else if (wsel == 2) PG8_WAIT_V(9); else PG8_WAIT_V(8); } else PG8_WAIT_V(8); } while (0)
#define PG8_WAIT_L(n) asm volatile("s_waitcnt lgkmcnt(" #n ")" ::: "memory")
#define PG8_BAR __builtin_amdgcn_s_barrier()
#define PG8_SCHED __builtin_amdgcn_sched_barrier(0)
    Unit cur, nxt; int ui = 0;
    if (!S.next(0, cur)) return;
    f32x4 acc[2][2][4][2];
    if constexpr (!(F8 && SP2))
#pragma unroll
    for (int a = 0; a < 2; ++a)
#pragma unroll
        for (int b = 0; b < 2; ++b)
#pragma unroll
            for (int m = 0; m < 4; ++m)
#pragma unroll
                for (int n = 0; n < 2; ++n) acc[a][b][m][n] = (f32x4){0.f, 0.f, 0.f, 0.f};
    bf16x8 At[4][2], B0[2][2], B1[2][2];
    s16x16 Atx[4], B0x[2], B1x[2];
    const int f8one = 0x7f7f7f7f;
    unsigned vA[2][2], nvA[2][2];
    if constexpr (GATHER) { PG8_ROWV(vA, 0); PG8_ROWV(nvA, 0); } else { vA[0][0] = vA[0][1] = vA[1][0] = vA[1][1] = 0u; nvA[0][0] = nvA[0][1] = nvA[1][0] = nvA[1][1] = 0u; }
    const char* cA = (const char*)g.A + (GATHER ? (size_t)0 : (size_t)cur.pm * tstep); const char* cB = (const char*)g.Bt + (size_t)cur.pn * tstepB + (size_t)cur.e * g.estride;
    S.a_ready(cur);
    if constexpr (SP2) {
        PG8_STAGE(PG8_SB(0, 0), cB, voffB); PG8_STAGE(PG8_SB(0, 1), cB + hstepB, voffB); PG8_STAGEA(PG8_SA(0, 0), cA, 0, false); PG8_STAGEA(PG8_SA(0, 1), cA, 1, false);
        if (wr == 1) PG8_BAR;
        PG8_WAIT_V(2); PG8_BAR;
        PG8_STAGE(PG8_SB(1, 0), cB + kstepB, voffB); PG8_STAGEA(PG8_SA(1, 0), cA + kstep, 0, false); PG8_STAGE(PG8_SB(1, 1), cB + hstepB + kstepB, voffB);
        PG8_WAIT_V(6); PG8_BAR;
    } else {
        PG8_STAGE(PG8_SB(0, 0), cB, voffB); PG8_STAGEA(PG8_SA(0, 0), cA, 0, false); PG8_STAGE(PG8_SB(0, 1), cB + hstepB, voffB); PG8_STAGEA(PG8_SA(0, 1), cA, 1, false);
        if (wr == 1) PG8_BAR;
        PG8_WAIT_V(4); PG8_BAR;
        PG8_STAGE(PG8_SB(1, 0), cB + kstepB, voffB); PG8_STAGEA(PG8_SA(1, 0), cA + kstep, 0, false); PG8_STAGE(PG8_SB(1, 1), cB + hstepB + kstepB, voffB);
        PG8_WAIT_V(6); PG8_BAR;
    }
    for (;;) {
        const bool has_next = S.next(ui + 1, nxt);
        if (g.rs_cnt != nullptr && ui >= 1 && ui < g.rs_rounds && tid == 0) {
            __hip_atomic_fetch_add(g.rs_cnt, 1u, __ATOMIC_RELAXED, __HIP_MEMORY_SCOPE_AGENT);
            const unsigned target = (unsigned)ui * g.rs_n; unsigned sp = 0;
            while (__hip_atomic_load(g.rs_cnt, __ATOMIC_RELAXED, __HIP_MEMORY_SCOPE_AGENT) < target && ++sp < 4096u) __builtin_amdgcn_s_sleep(4);
        }
        if constexpr (GATHER) { if (has_next) { PG8_ROWV(nvA, ui + 1); } else { nvA[0][0] = vA[0][0]; nvA[0][1] = vA[0][1]; nvA[1][0] = vA[1][0]; nvA[1][1] = vA[1][1]; } }
        const char* nA = has_next ? (const char*)g.A + (GATHER ? (size_t)0 : (size_t)nxt.pm * tstep) : cA; const char* nB = has_next ? (const char*)g.Bt + (size_t)nxt.pn * tstepB + (size_t)nxt.e * g.estride : cB;
        for (int t = 0; t < nt; t += 2) {
            const bool last = (t == nt - 2);
            const char* a1 = cA + (size_t)(t + 1) * kstep;
            const char* a2 = last ? nA : cA + (size_t)(t + 2) * kstep; const char* b2 = last ? nB : cB + (size_t)(t + 2) * kstepB;
            const char* a3 = a2 + kstep; const char* b3 = b2 + kstepB;
            if (last && has_next) S.a_ready(nxt);
            const int wsel = (t == 0 && ui > 0 && !last) ? 1 : ((last && Epi::LDSOPS) ? 2 : 0);
            if constexpr (Epi::LDSOPS) { if (last) E.prefetch(cur, wid, lane); }
            if constexpr (SP2) {
            PG8_LDB(B0, 0, 0); PG8_LDB(B1, 0, 1); PG8_SCHED; PG8_LDA(At, 0, 0); PG8_STAGEA(PG8_SA(1, 1), a1, 1, false);
            PG8_WAIT_VS(); PG8_WAIT_L(0); PG8_BAR; PG8_MMA0(0, 0, At, B0); PG8_MMA0(0, 1, At, B1); PG8_BAR; PG8_SCHED;
            PG8_LDA(At, 0, 1); PG8_STAGE(PG8_SB(0, 0), b2, voffB); PG8_STAGE(PG8_SB(0, 1), b2 + hstepB, voffB); PG8_STAGEA(PG8_SA(0, 0), a2, 0, last);
            PG8_WAIT_VS(); PG8_WAIT_L(0); PG8_BAR; PG8_MMA0(1, 0, At, B0); PG8_MMA0(1, 1, At, B1); PG8_BAR; PG8_SCHED;
            PG8_LDB(B0, 1, 0); PG8_LDB(B1, 1, 1); PG8_SCHED; PG8_LDA(At, 1, 0); PG8_STAGEA(PG8_SA(0, 1), a2, 1, last);
            PG8_WAIT_V(8); PG8_WAIT_L(0); PG8_BAR; PG8_MMA(0, 0, At, B0); PG8_MMA(0, 1, At, B1); PG8_BAR; PG8_SCHED;
            PG8_LDA(At, 1, 1); PG8_STAGE(PG8_SB(1, 0), b3, voffB); PG8_STAGE(PG8_SB(1, 1), b3 + hstepB, voffB); PG8_STAGEA(PG8_SA(1, 0), a3, 0, last);
            PG8_WAIT_V(8); PG8_WAIT_L(0); PG8_BAR; PG8_MMA(1, 0, At, B0); PG8_MMA(1, 1, At, B1); PG8_BAR; PG8_SCHED;
            } else {
            PG8_LDB(B0, 0, 0); PG8_SCHED; PG8_LDA(At, 0, 0); PG8_STAGEA(PG8_SA(1, 1), a1, 1, false);
            PG8_WAIT_L(8); PG8_BAR; PG8_WAIT_L(0); PG8_MMA(0, 0, At, B0); PG8_BAR; PG8_SCHED;
            PG8_LDB(B1, 0, 1); PG8_STAGE(PG8_SB(0, 0), b2, voffB);
            PG8_BAR; PG8_WAIT_L(0); PG8_MMA(0, 1, At, B1); PG8_BAR;
            PG8_LDA(At, 0, 1); PG8_STAGEA(PG8_SA(0, 0), a2, 0, last);
            PG8_BAR; PG8_WAIT_L(0); PG8_MMA(1, 0, At, B0); PG8_BAR; PG8_SCHED;
            PG8_STAGE(PG8_SB(0, 1), b2 + hstepB, voffB);
            PG8_WAIT_V(6); PG8_BAR; PG8_MMA(1, 1, At, B1); PG8_BAR;
            PG8_LDB(B0, 1, 0); PG8_SCHED; PG8_LDA(At, 1, 0); PG8_STAGEA(PG8_SA(0, 1), a2, 1, last);
            PG8_WAIT_L(8); PG8_BAR; PG8_WAIT_L(0); PG8_MMA(0, 0, At, B0); PG8_BAR; PG8_SCHED;
            PG8_LDB(B1, 1, 1); PG8_STAGE(PG8_SB(1, 0), b3, voffB);
            PG8_BAR; PG8_WAIT_L(0); PG8_MMA(0, 1, At, B1); PG8_BAR;
            PG8_LDA(At, 1, 1); PG8_STAGEA(PG8_SA(1, 0), a3, 0, last);
            PG8_BAR; PG8_WAIT_L(0); PG8_MMA(1, 0, At, B0); PG8_BAR; PG8_SCHED;
            PG8_STAGE(PG8_SB(1, 1), b3 + hstepB, voffB);
            PG8_WAIT_V(6); PG8_BAR; PG8_MMA(1, 1, At, B1); PG8_BAR;
            }
        }
        if constexpr (F8) { asm volatile("s_nop 15\n\ts_nop 15" ::: "memory"); }
        if constexpr (ALIGN_EPI) { if (wr == 0) PG8_BAR; }
        if constexpr (!Epi::AFTER_DRAIN) { E(acc, cur, wr, wc, fr, fq); S.done(cur); }
        if (!has_next) break;
        if constexpr (!(F8 && SP2))
#pragma unroll
        for (int a = 0; a < 2; ++a)
#pragma unroll
            for (int b = 0; b < 2; ++b)
#pragma unroll
                for (int m = 0; m < 4; ++m)
#pragma unroll
                    for (int n = 0; n < 2; ++n) acc[a][b][m][n] = (f32x4){0.f, 0.f, 0.f, 0.f};
        cur = nxt; cA = nA; cB = nB; ++ui; if constexpr (GATHER) { vA[0][0] = nvA[0][0]; vA[0][1] = nvA[0][1]; vA[1][0] = nvA[1][0]; vA[1][1] = nvA[1][1]; }
        if constexpr (ALIGN_EPI) { if (wr == 1) PG8_BAR; }
    }
    PG8_WAIT_V(0);
    if constexpr (!ALIGN_EPI) { if (wr == 0) PG8_BAR; }
    PG8_BAR;
    if constexpr (Epi::AFTER_DRAIN) { E.fused(acc, cur, wr, wc, fr, fq, lds, wid, lane); S.done(cur); }
#undef PG8_SA
#undef PG8_SB
#undef PG8_STAGE
#undef PG8_STAGEA
#undef PG8_ROWV
#undef PG8_CAT16
#undef PG8_LDA
#undef PG8_LDB
#undef PG8_MMA
#undef PG8_MMAZ
#undef PG8_MMA0
#undef PG8_WAIT_V
#undef PG8_WAIT_VS
#undef PG8_WAIT_L
#undef PG8_BAR
#undef PG8_SCHED
}
}
#define XB_TMO      128
#define XB_XCNT(j)  (256  + 64 * (j))
#define XB_XSUB(j)  (1280 + 64 * (j))
#define XB_XGEN(j)  (2304 + 64 * (j))
#define XB_TOP      3328
#define XB_TOPGEN   3392
#define XCD_BAR_WORDS 3456
#define XB_SPIN_CAP (1u << 18)

__device__ __forceinline__ unsigned xb_ld(unsigned* p)              { return __hip_atomic_load(p, __ATOMIC_RELAXED, __HIP_MEMORY_SCOPE_AGENT); }
__device__ __forceinline__ unsigned xb_add(unsigned* p, unsigned v) { return __hip_atomic_fetch_add(p, v, __ATOMIC_RELAXED, __HIP_MEMORY_SCOPE_AGENT); }
__device__ __forceinline__ unsigned xb_xcc_id() { return (unsigned)__builtin_amdgcn_s_getreg((3 << 11) | 20) & 0xFu; }
#define XB_SPIN(cond, bar) do { unsigned _sp = 0; while (cond) { __builtin_amdgcn_s_sleep(1); \
    if ((++_sp & 255u) == 0u) { if (xb_ld(&(bar)[XB_TMO])) break; if (_sp > XB_SPIN_CAP) { atomicAdd(&(bar)[XB_TMO], 1u); break; } } } } while (0)

struct XcdBarrier {
    unsigned* bar; unsigned x;
    volatile LAS unsigned* st;
};

__device__ __forceinline__ XcdBarrier xcd_barrier_post(unsigned* bar, volatile LAS unsigned* st) {
    XcdBarrier b; b.bar = bar; b.x = xb_xcc_id(); b.st = st;
    if (threadIdx.x == 0) (void)xb_add(&bar[XB_XCNT(b.x)], 1u);
    return b;
}
__device__ __forceinline__ void xcd_barrier_complete(unsigned* bar, unsigned x, unsigned& nloc, unsigned& nx) {
    const unsigned G = gridDim.x * gridDim.y * gridDim.z;
    unsigned sum, cnt, mine, sp = 0u;
    for (;;) {
        sum = 0u; cnt = 0u; mine = 0u;
#pragma unroll
        for (unsigned j = 0; j < 16; ++j) { const unsigned c = xb_ld(&bar[XB_XCNT(j)]); sum += c; cnt += (c > 0u) ? 1u : 0u; mine = (j == x) ? c : mine; }
        if (sum == G) break;
        __builtin_amdgcn_s_sleep(1);
        if ((++sp & 255u) == 0u) { if (xb_ld(&bar[XB_TMO])) break; if (sp > XB_SPIN_CAP) { atomicAdd(&bar[XB_TMO], 1u); break; } }
    }
    nloc = mine > 0u ? mine : 1u; nx = cnt > 0u ? cnt : 1u;
}

__device__ __forceinline__ void xcd_barrier(const XcdBarrier& b) {
    asm volatile("s_waitcnt vmcnt(0)" ::: "memory");
    __syncthreads();
    if (threadIdx.x == 0) {
        unsigned* bar = b.bar;
        __builtin_amdgcn_s_waitcnt(0);
        unsigned nloc = b.st[0], nx = b.st[1];
        if (nloc == 0u) { xcd_barrier_complete(bar, b.x, nloc, nx); b.st[0] = nloc; b.st[1] = nx; }
        const unsigned old = xb_add(&bar[XB_XSUB(b.x)], 1u);
        const unsigned gen = old / nloc;
        if (old + 1u == (gen + 1u) * nloc) {
            __builtin_amdgcn_fence(__ATOMIC_RELEASE, "agent");
            asm volatile("s_waitcnt vmcnt(0)" ::: "memory");
            const unsigned og = xb_add(&bar[XB_TOP], 1u);
            const unsigned tg = og / nx;
            if (og + 1u == (tg + 1u) * nx) xb_add(&bar[XB_TOPGEN], 1u);
            else XB_SPIN(xb_ld(&bar[XB_TOPGEN]) == tg, bar);
            __builtin_amdgcn_fence(__ATOMIC_ACQUIRE, "agent");
            xb_add(&bar[XB_XGEN(b.x)], 1u);
            asm volatile("s_waitcnt vmcnt(0)" ::: "memory");
        } else {
            XB_SPIN(xb_ld(&bar[XB_XGEN(b.x)]) == gen, bar);
            __builtin_amdgcn_fence(__ATOMIC_ACQUIRE, "agent");
            asm volatile("s_waitcnt vmcnt(0)" ::: "memory");
        }
    }
    __syncthreads();
}

constexpr int NWAVES = 8;
constexpr int T_ = 16384, D_ = 2048, NH = 8, HD = 128, AW = 1024, RW = 1024, NE = 32, TOPK = 4, DFF = 2048;
constexpr int INW = 9216, PW = 8192;
constexpr int PQ = 0, PK = 1024, PRX = 2048, PRG = 3072, PGA = 4096, PGB = 6144;
constexpr int NROWS = T_ * TOPK + NE * 256, NBLK = NROWS / 256;
constexpr int NSEG = 256, SEG = 64;
constexpr float EPS_ = 1e-6f;
constexpr int N_PHASES = 12;
#ifndef MOE_CVT_IN_GEMM
#define MOE_CVT_IN_GEMM 0
#endif
#ifndef MOE_FP8
#define MOE_FP8 1
#endif
#ifndef INPROJ_FP8
#define INPROJ_FP8 1
#endif
#ifndef MIX_FP8
#define MIX_FP8 1
#endif
#ifndef ROUND_SYNC
#define ROUND_SYNC 0
#endif
#ifndef WPITCH
#define WPITCH 2176
#endif
#ifndef YD_FP8
#define YD_FP8 1
#endif
#ifndef MK_ONE_LAUNCH
#define MK_ONE_LAUNCH 1
#endif

constexpr size_t MiB = 1u << 20, KiB = 1u << 10;
constexpr size_t WS_CTL = 0, CTL_ZERO_BYTES = 1 * MiB;
constexpr size_t WS_MOD = 1 * MiB;
constexpr size_t WS_HIST = 1 * MiB + 64 * KiB;
constexpr size_t WS_PLAN = 1 * MiB + 128 * KiB;
constexpr size_t WS_TOPE = 2 * MiB, WS_TOPW = 2 * MiB + 256 * KiB, WS_POS = 2 * MiB + 512 * KiB;
constexpr size_t WS_ROWW = 3 * MiB + 512 * KiB;
constexpr size_t WS_ROWTOK = 3 * MiB;
constexpr size_t WS_SEGA = 4 * MiB, WS_SEGH = 5 * MiB;
constexpr size_t WS_WAT = 6 * MiB, WS_WXT = 6 * MiB + 256 * KiB;
constexpr size_t WS_WRT = 6 * MiB + 512 * KiB, WS_RB = 6 * MiB + 768 * KiB;
constexpr size_t WS_WIN = 8 * MiB;
constexpr size_t WS_WV = 40 * MiB;
constexpr size_t WS_WAU = 44 * MiB, WS_WRU = 48 * MiB;
constexpr size_t WS_WOUT = 52 * MiB;
constexpr size_t WS_WGU = 64 * MiB;
constexpr size_t WS_WDN = 576 * MiB;
constexpr size_t WS_XN = 832 * MiB;
constexpr size_t WS_P8 = 897 * MiB;
constexpr size_t WS_VT = 1153 * MiB;
constexpr size_t WS_YA = 1185 * MiB, WS_YB = 1217 * MiB;
constexpr size_t WS_T1 = 1249 * MiB;
constexpr size_t WS_MG = 1377 * MiB;
constexpr size_t WS_HL = 1441 * MiB, WS_AC = 1505 * MiB;
constexpr size_t WS_ACT = 1569 * MiB;
constexpr size_t WS_YD = 1857 * MiB;
constexpr size_t WS_XB = 2145 * MiB;
constexpr size_t WS_QH = 2433 * MiB, WS_KH = 2465 * MiB;
constexpr size_t WS_END = 2497 * MiB;
constexpr int CW_RS = 16384;
constexpr int CW_RANK = 12288;
#ifndef CVT_Q2
#define CVT_Q2 96
#endif
#ifndef CVT_HOST
#define CVT_HOST 2
#endif
constexpr int CW_Q = 24576;
constexpr int CW_BAR = 4096;

constexpr int LDS_BYTES = 163840, MISC_OFF = LDS_BYTES - 256, ROWTAB_OFF = 131072, EPI_OFF = 155648;

typedef unsigned short bf16;
typedef unsigned u32x2 __attribute__((ext_vector_type(2)));
typedef unsigned u32x4 __attribute__((ext_vector_type(4)));
typedef float f32x2 __attribute__((ext_vector_type(2)));
typedef float f32x4 __attribute__((ext_vector_type(4)));
typedef float f32x16 __attribute__((ext_vector_type(16)));
typedef short bf16x8 __attribute__((ext_vector_type(8)));
typedef __bf16 bf16x2_t __attribute__((ext_vector_type(2)));

__device__ __forceinline__ unsigned pk2(float lo, float hi) { f32x2 v = {lo, hi}; bf16x2_t b = __builtin_convertvector(v, bf16x2_t); return __builtin_bit_cast(unsigned, b); }
__device__ __forceinline__ float bflo(unsigned w) { return __uint_as_float(w << 16); }
__device__ __forceinline__ float bfhi(unsigned w) { return __uint_as_float(w & 0xffff0000u); }
__device__ __forceinline__ float sigmoidf_(float x) { return __builtin_amdgcn_rcpf(1.0f + __builtin_amdgcn_exp2f(-1.44269504089f * x)); }
__device__ __forceinline__ float gelu_tanh(float x) { const float u = -2.30220819813f * (x + 0.044715f * x * x * x); return x * __builtin_amdgcn_rcpf(1.0f + __builtin_amdgcn_exp2f(u)); }
__device__ __forceinline__ f32x2 sigmoid2(f32x2 x) { const f32x2 z = x * -1.44269504089f; const f32x2 d = (f32x2){__builtin_amdgcn_exp2f(z.x), __builtin_amdgcn_exp2f(z.y)} + 1.0f; return (f32x2){__builtin_amdgcn_rcpf(d.x), __builtin_amdgcn_rcpf(d.y)}; }
__device__ __forceinline__ f32x2 bf2(unsigned w) { return (f32x2){bflo(w), bfhi(w)}; }
__device__ __forceinline__ float clamp448(float x) { return fminf(fmaxf(x, -448.0f), 448.0f); }
__device__ __forceinline__ unsigned pk4_fp8(float a, float b, float c2, float d) {
    int p = 0; p = __builtin_amdgcn_cvt_pk_fp8_f32(clamp448(a), clamp448(b), p, false); p = __builtin_amdgcn_cvt_pk_fp8_f32(clamp448(c2), clamp448(d), p, true); return (unsigned)p; }
__device__ __forceinline__ unsigned pk4_fp8_nc(float a, float b, float c2, float d) {
    int p = 0; p = __builtin_amdgcn_cvt_pk_fp8_f32(a, b, p, false); p = __builtin_amdgcn_cvt_pk_fp8_f32(c2, d, p, true); return (unsigned)p; }
__device__ __forceinline__ float wave_sum(float v) {
#pragma unroll
    for (int o = 1; o < 64; o <<= 1) v += __shfl_xor(v, o);
    return v;
}
__device__ __forceinline__ int crow(int reg, int h) { return (reg & 3) + 8 * (reg >> 2) + 4 * h; }

struct Frame {
    LAS unsigned char* lds;
    int tid, lane, wave, G, bx, vbx;
    const float* in[26]; float* out; unsigned char* ws;
};
#define WSP(T, off) ((T*)(F.ws + (off)))

namespace pg8 {
struct EpiStoreBf16 {
    static constexpr bool PERM = true, AFTER_DRAIN = false;
    static constexpr int NST = 16; static constexpr bool LDSOPS = false;
    bf16_t* O; int ldc; float sc;
    __device__ __forceinline__ void operator()(const f32x4 (&acc)[2][2][4][2], const Unit& u, int wr, int wc, int fr, int fq) const {
        const int row0 = u.pm * BM + wr * 64 + fr, col0 = u.pn * BM + wc * 32 + 8 * fq;
#pragma unroll
        for (int ai = 0; ai < 2; ++ai)
#pragma unroll
            for (int m = 0; m < 4; ++m) { bf16_t* rowp = O + (size_t)(row0 + ai * HALF + m * 16) * ldc + col0;
#pragma unroll
                for (int bj = 0; bj < 2; ++bj) { const f32x4 v0 = acc[ai][bj][m][0] * sc, v1 = acc[ai][bj][m][1] * sc;
                    u32x4 w; w.x = pk2(v0[0], v0[1]); w.y = pk2(v0[2], v0[3]); w.z = pk2(v1[0], v1[1]); w.w = pk2(v1[2], v1[3]);
                    *(u32x4*)(rowp + bj * HALF) = w; } }
    }
};
struct EpiProj {
    static constexpr bool PERM = true, AFTER_DRAIN = false;
    static constexpr int NST = 0; static constexpr bool LDSOPS = false;
    bf16_t* O; int ldc; float sc; bf16_t* QH; bf16_t* KH; const float* qg; const float* kg; LAS float* red;
    __device__ __forceinline__ void operator()(const f32x4 (&acc)[2][2][4][2], const Unit& u, int wr, int wc, int fr, int fq) const {
        const int row0 = u.pm * BM + wr * 64 + fr;
        if (u.pn >= 8) {
            const int col0 = u.pn * BM + wc * 32 + 8 * fq;
#pragma unroll
            for (int ai = 0; ai < 2; ++ai)
#pragma unroll
                for (int m = 0; m < 4; ++m) { bf16_t* rowp = O + (size_t)(row0 + ai * HALF + m * 16) * ldc + col0;
#pragma unroll
                    for (int bj = 0; bj < 2; ++bj) { const f32x4 v0 = acc[ai][bj][m][0] * sc, v1 = acc[ai][bj][m][1] * sc;
                        u32x4 w; w.x = pk2(v0[0], v0[1]); w.y = pk2(v0[2], v0[3]); w.z = pk2(v1[0], v1[1]); w.w = pk2(v1[2], v1[3]);
                        *(u32x4*)(rowp + bj * HALF) = w; } }
            return;
        }
#pragma unroll
        for (int ai = 0; ai < 2; ++ai)
#pragma unroll
            for (int m = 0; m < 4; ++m)
#pragma unroll
                for (int bj = 0; bj < 2; ++bj) { const f32x4 v0 = acc[ai][bj][m][0] * sc, v1 = acc[ai][bj][m][1] * sc;
                    float ss = (v0[0] * v0[0] + v0[1] * v0[1]) + (v0[2] * v0[2] + v0[3] * v0[3]) + (v1[0] * v1[0] + v1[1] * v1[1]) + (v1[2] * v1[2] + v1[3] * v1[3]);
                    ss += __shfl_xor(ss, 16); ss += __shfl_xor(ss, 32);
                    if (fq == 0) red[((ai * HALF + wr * 64 + m * 16 + fr) * 2 + bj) * 4 + wc] = ss; }
        asm volatile("s_waitcnt lgkmcnt(0)" ::: "memory"); __builtin_amdgcn_s_barrier(); asm volatile("" ::: "memory");
        const bool isk = u.pn >= 4; const int hbase = (isk ? u.pn - 4 : u.pn) * 2, d0 = wc * 32 + 8 * fq;
        const float* gp = (isk ? kg : qg) + d0; const float gs = isk ? 1.0f : (0.08838834764831845f * 1.44269504089f);
        const f32x4 g0 = *(const f32x4*)gp * gs, g1 = *(const f32x4*)(gp + 4) * gs;
        bf16_t* dst = isk ? KH : QH;
#pragma unroll
        for (int ai = 0; ai < 2; ++ai)
#pragma unroll
            for (int m = 0; m < 4; ++m)
#pragma unroll
                for (int bj = 0; bj < 2; ++bj) { const int rl = ai * HALF + wr * 64 + m * 16 + fr; const f32x4 pr = *(const LAS f32x4*)(red + (rl * 2 + bj) * 4);
                    const float rs = rsqrtf(((pr[0] + pr[1]) + (pr[2] + pr[3])) * (1.0f / 128.0f) + 1e-6f) * sc;
                    const f32x4 v0 = acc[ai][bj][m][0] * rs * g0, v1 = acc[ai][bj][m][1] * rs * g1;
                    u32x4 w; w.x = pk2(v0[0], v0[1]); w.y = pk2(v0[2], v0[3]); w.z = pk2(v1[0], v1[1]); w.w = pk2(v1[2], v1[3]);
                    *(u32x4*)(dst + ((size_t)(hbase + bj) * 16384 + (size_t)(row0 + ai * HALF + m * 16)) * 128 + d0) = w; }
    }
};
struct EpiVtb {
    static constexpr bool PERM = true, AFTER_DRAIN = false;
    static constexpr int NST = 16; static constexpr bool LDSOPS = false;
    bf16_t* O; float sc;
    __device__ __forceinline__ void operator()(const f32x4 (&acc)[2][2][4][2], const Unit& u, int wr, int wc, int fr, int fq) const {
        const int row0 = u.pm * BM + wr * 64 + fr, col0 = u.pn * BM + wc * 32 + 8 * fq;
#pragma unroll
        for (int ai = 0; ai < 2; ++ai)
#pragma unroll
            for (int m = 0; m < 4; ++m) { const int R = row0 + ai * HALF + m * 16;
#pragma unroll
                for (int bj = 0; bj < 2; ++bj) { const int C = col0 + bj * HALF; const f32x4 v0 = acc[ai][bj][m][0] * sc, v1 = acc[ai][bj][m][1] * sc;
                    u32x4 w; w.x = pk2(v0[0], v0[1]); w.y = pk2(v0[2], v0[3]); w.z = pk2(v1[0], v1[1]); w.w = pk2(v1[2], v1[3]);
                    *(u32x4*)(O + ((((size_t)(R >> 7) * 256 + (C >> 6)) * 128 + (R & 127)) * 64 + (C & 63))) = w; } }
    }
};
struct EpiMerge1 {
    static constexpr bool PERM = true, AFTER_DRAIN = false;
    static constexpr int NST = 16; static constexpr bool LDSOPS = false;
    float* T1; const bf16_t* Gt; int ldg; float sc;
    __device__ __forceinline__ void operator()(const f32x4 (&acc)[2][2][4][2], const Unit& u, int wr, int wc, int fr, int fq) const {
        const int row0 = u.pm * BM + wr * 64 + fr, col0 = u.pn * BM + wc * 32 + 8 * fq;
        u32x4 gwv[2][4][2];
#pragma unroll
        for (int ai = 0; ai < 2; ++ai)
#pragma unroll
            for (int m = 0; m < 4; ++m)
#pragma unroll
                for (int bj = 0; bj < 2; ++bj) gwv[ai][m][bj] = *(const u32x4*)(Gt + (size_t)(row0 + ai * HALF + m * 16) * ldg + col0 + bj * HALF);
#pragma unroll
        for (int ai = 0; ai < 2; ++ai)
#pragma unroll
            for (int m = 0; m < 4; ++m) { const size_t row = (size_t)(row0 + ai * HALF + m * 16);
#pragma unroll
                for (int bj = 0; bj < 2; ++bj) { const int col = col0 + bj * HALF;
                    const u32x4 gw = gwv[ai][m][bj];
                    const f32x4 a0 = acc[ai][bj][m][0], a1 = acc[ai][bj][m][1];
                    const f32x2 p0 = sigmoid2(bf2(gw.x)) * ((f32x2){a0[0], a0[1]} * sc), p1 = sigmoid2(bf2(gw.y)) * ((f32x2){a0[2], a0[3]} * sc), p2 = sigmoid2(bf2(gw.z)) * ((f32x2){a1[0], a1[1]} * sc), p3 = sigmoid2(bf2(gw.w)) * ((f32x2){a1[2], a1[3]} * sc);
                    u32x4 tw; tw.x = pk2(p0.x, p0.y); tw.y = pk2(p1.x, p1.y); tw.z = pk2(p2.x, p2.y); tw.w = pk2(p3.x, p3.y);
                    *(u32x4*)((bf16_t*)T1 + row * 2048 + col) = tw; } }
    }
};
struct EpiMerge2 {
    static constexpr bool PERM = true, AFTER_DRAIN = false;
    static constexpr int NST = 8; static constexpr bool LDSOPS = false;
    const float* T1; const bf16_t* Gt; int ldg; bf16_t* MG; float sc;
    __device__ __forceinline__ void operator()(const f32x4 (&acc)[2][2][4][2], const Unit& u, int wr, int wc, int fr, int fq) const {
        const int row0 = u.pm * BM + wr * 64 + fr, col0 = u.pn * BM + wc * 32 + 8 * fq;
#pragma unroll
        for (int ai = 0; ai < 2; ++ai) {
        u32x4 gwv[4][2], twv[4][2];
#pragma unroll
            for (int m = 0; m < 4; ++m)
#pragma unroll
                for (int bj = 0; bj < 2; ++bj) { const size_t row = (size_t)(row0 + ai * HALF + m * 16); const int col = col0 + bj * HALF;
                    gwv[m][bj] = *(const u32x4*)(Gt + row * ldg + col); twv[m][bj] = *(const u32x4*)((const bf16_t*)T1 + row * 2048 + col); }
#pragma unroll
            for (int m = 0; m < 4; ++m) { const size_t row = (size_t)(row0 + ai * HALF + m * 16);
#pragma unroll
                for (int bj = 0; bj < 2; ++bj) { const int col = col0 + bj * HALF;
                    const u32x4 gw = gwv[m][bj];
                    const u32x4 tw = twv[m][bj];
                    const f32x4 a0 = acc[ai][bj][m][0], a1 = acc[ai][bj][m][1];
                    const f32x2 q0 = bf2(tw.x) + sigmoid2(bf2(gw.x)) * ((f32x2){a0[0], a0[1]} * sc), q1 = bf2(tw.y) + sigmoid2(bf2(gw.y)) * ((f32x2){a0[2], a0[3]} * sc), q2 = bf2(tw.z) + sigmoid2(bf2(gw.z)) * ((f32x2){a1[0], a1[1]} * sc), q3 = bf2(tw.w) + sigmoid2(bf2(gw.w)) * ((f32x2){a1[2], a1[3]} * sc);
                    const f32x4 o0 = {q0.x, q0.y, q1.x, q1.y}, o1 = {q2.x, q2.y, q3.x, q3.y};
#if MIX_FP8
                    const f32x4 s0 = o0 * 64.0f, s1 = o1 * 64.0f;
                    u32x2 w8; w8.x = pk4_fp8(s0[0], s0[1], s0[2], s0[3]); w8.y = pk4_fp8(s1[0], s1[1], s1[2], s1[3]);
                    *(u32x2*)((unsigned char*)MG + row * 2048 + col) = w8; } }
#else
                    u32x4 w; w.x = pk2(o0[0], o0[1]); w.y = pk2(o0[2], o0[3]); w.z = pk2(o1[0], o1[1]); w.w = pk2(o1[2], o1[3]);
                    *(u32x4*)(MG + row * 2048 + col) = w; } }
#endif
        }
    }
};
struct EpiOut {
    static constexpr bool PERM = false, AFTER_DRAIN = false;
    static constexpr int NST = 16; static constexpr bool LDSOPS = false;
    const float* X; const float* g1; float* H1; float sc;
    __device__ __forceinline__ void operator()(const f32x4 (&acc)[2][2][4][2], const Unit& u, int wr, int wc, int fr, int fq) const {
        const int row0 = u.pm * BM + wr * 64 + fr, col0 = u.pn * BM + wc * 32 + 4 * fq;
        f32x4 gv[2][2];
#pragma unroll
        for (int bj = 0; bj < 2; ++bj)
#pragma unroll
            for (int n = 0; n < 2; ++n) gv[bj][n] = *(const f32x4*)(g1 + col0 + bj * HALF + n * 16) * sc;
#pragma unroll
        for (int ai = 0; ai < 2; ++ai) {
            f32x4 xv[4][2][2];
#pragma unroll
            for (int m = 0; m < 4; ++m)
#pragma unroll
                for (int bj = 0; bj < 2; ++bj)
#pragma unroll
                    for (int n = 0; n < 2; ++n) xv[m][bj][n] = *(const f32x4*)(X + (size_t)(row0 + ai * HALF + m * 16) * 2048 + col0 + bj * HALF + n * 16);
#pragma unroll
            for (int m = 0; m < 4; ++m) { const size_t off = (size_t)(row0 + ai * HALF + m * 16) * 2048 + col0;
#pragma unroll
                for (int bj = 0; bj < 2; ++bj)
#pragma unroll
                    for (int n = 0; n < 2; ++n) *(f32x4*)(H1 + off + bj * HALF + n * 16) = xv[m][bj][n] + gv[bj][n] * acc[ai][bj][m][n]; }
        }
    }
};
struct EpiSwiGLU {
    static constexpr bool PERM = true, AFTER_DRAIN = false;
    static constexpr int NST = 0; static constexpr bool LDSOPS = false;
    const float* bgu; bf16_t* ACT;
    __device__ __forceinline__ void operator()(const f32x4 (&acc)[2][2][4][2], const Unit& u, int wr, int wc, int fr, int fq) const {
        const int row0 = u.pm * BM + wr * 64 + fr, colA = u.pn * HALF + wc * 32 + 8 * fq;
        const float* bb = bgu + (size_t)u.e * 4096 + colA;
        const f32x4 bg0 = *(const f32x4*)(bb), bg1 = *(const f32x4*)(bb + 4), bu0 = *(const f32x4*)(bb + 2048), bu1 = *(const f32x4*)(bb + 2048 + 4);
#pragma unroll
        for (int ai = 0; ai < 2; ++ai)
#pragma unroll
            for (int m = 0; m < 4; ++m) { const size_t row = (size_t)(row0 + ai * HALF + m * 16);
                f32x4 o[2];
#pragma unroll
                for (int n = 0; n < 2; ++n) { const f32x4 gt = acc[ai][0][m][n] + (n ? bg1 : bg0), up = acc[ai][1][m][n] + (n ? bu1 : bu0);
#pragma unroll
                    for (int j = 0; j < 4; ++j) { const float g = fminf(gt[j], 7.0f), uu = fminf(fmaxf(up[j], -7.0f), 7.0f);
                        o[n][j] = (uu + 1.0f) * (g * __builtin_amdgcn_rcpf(1.0f + __builtin_amdgcn_exp2f(-2.45546695959f * g))); } }
                u32x4 w; w.x = pk2(o[0][0], o[0][1]); w.y = pk2(o[0][2], o[0][3]); w.z = pk2(o[1][0], o[1][1]); w.w = pk2(o[1][2], o[1][3]);
                *(u32x4*)(ACT + row * 2048 + colA) = w; }
    }
};
struct EpiSwiGLU8 {
    static constexpr bool PERM = true, AFTER_DRAIN = false;
    static constexpr int NST = 8; static constexpr bool LDSOPS = true;
    const float* bgu; unsigned char* ACT; LAS unsigned char* lds;
    __device__ __forceinline__ void prefetch(const Unit& u, int wid, int lane) const {
        const int idx = (wid & 3) * 64 + lane; const float* src = bgu + (size_t)u.e * 4096 + u.pn * HALF + (idx < 128 ? idx : 2048 + idx - 128);
        __builtin_amdgcn_global_load_lds((const unsigned*)src, (LAS unsigned*)(lds + EPI_OFF + wid * 256), 4, 0, 0);
    }
    __device__ __forceinline__ void operator()(const f32x4 (&acc)[2][2][4][2], const Unit& u, int wr, int wc, int fr, int fq) const {
        const int row0 = u.pm * BM + wr * 64 + fr, colA = u.pn * HALF + wc * 32 + 8 * fq;
        const LAS float* bb = (const LAS float*)(lds + EPI_OFF) + wc * 32 + 8 * fq;
        const f32x4 bg0 = *(const LAS f32x4*)(bb), bg1 = *(const LAS f32x4*)(bb + 4), bu0 = *(const LAS f32x4*)(bb + 128), bu1 = *(const LAS f32x4*)(bb + 128 + 4);
#pragma unroll
        for (int ai = 0; ai < 2; ++ai)
#pragma unroll
            for (int m = 0; m < 4; ++m) { const size_t row = (size_t)(row0 + ai * HALF + m * 16);
                f32x4 o[2];
#pragma unroll
                for (int n = 0; n < 2; ++n)
#pragma unroll
                    for (int jp = 0; jp < 2; ++jp) { const f32x4 ag = acc[ai][0][m][n], au = acc[ai][1][m][n], bgv = n ? bg1 : bg0, buv = n ? bu1 : bu0;
                        const f32x2 gt = (f32x2){ag[2 * jp], ag[2 * jp + 1]} * 0.0001220703125f + (f32x2){bgv[2 * jp], bgv[2 * jp + 1]}, up = (f32x2){au[2 * jp], au[2 * jp + 1]} * 0.0001220703125f + (f32x2){buv[2 * jp], buv[2 * jp + 1]};
                        const f32x2 g = {fminf(gt.x, 7.0f), fminf(gt.y, 7.0f)}, uu = {fminf(fmaxf(up.x, -7.0f), 7.0f), fminf(fmaxf(up.y, -7.0f), 7.0f)};
                        const f32x2 z = g * -2.45546695959f;
                        const f32x2 d = (f32x2){__builtin_amdgcn_exp2f(z.x), __builtin_amdgcn_exp2f(z.y)} + 1.0f;
                        const f32x2 r = {__builtin_amdgcn_rcpf(d.x), __builtin_amdgcn_rcpf(d.y)};
                        const f32x2 ov = (uu * 4.0f + 4.0f) * (g * r);
                        o[n][2 * jp] = ov.x; o[n][2 * jp + 1] = ov.y; }
                u32x2 w; w.x = pk4_fp8_nc(o[0][0], o[0][1], o[0][2], o[0][3]); w.y = pk4_fp8_nc(o[1][0], o[1][1], o[1][2], o[1][3]);
                *(u32x2*)(ACT + row * 2048 + colA) = w; }
    }
};
struct EpiDown {
    static constexpr bool PERM = true, AFTER_DRAIN = false;
    static constexpr int NST = 16; static constexpr bool LDSOPS = true;
    const float* bd; const float* roww; bf16_t* YD; float sc; LAS unsigned char* lds;
    __device__ __forceinline__ void prefetch(const Unit& u, int wid, int lane) const {
        const int idx = (wid & 3) * 64 + lane; const float* src = wid < 4 ? bd + (size_t)u.e * 2048 + u.pn * BM + idx : roww + (size_t)u.pm * BM + idx;
        __builtin_amdgcn_global_load_lds((const unsigned*)src, (LAS unsigned*)(lds + EPI_OFF + wid * 256), 4, 0, 0);
    }
    __device__ __forceinline__ void operator()(const f32x4 (&acc)[2][2][4][2], const Unit& u, int wr, int wc, int fr, int fq) const {
        const int row0 = u.pm * BM + wr * 64 + fr, col0 = u.pn * BM + wc * 32 + 8 * fq;
        const LAS float* bb = (const LAS float*)(lds + EPI_OFF) + wc * 32 + 8 * fq; const LAS float* rwp = (const LAS float*)(lds + EPI_OFF) + 256 + wr * 64 + fr;
        f32x4 bv[2][2];
#pragma unroll
        for (int bj = 0; bj < 2; ++bj)
#pragma unroll
            for (int n = 0; n < 2; ++n) bv[bj][n] = *(const LAS f32x4*)(bb + bj * HALF + 4 * n);
        float rwv[2][4];
#pragma unroll
        for (int ai = 0; ai < 2; ++ai)
#pragma unroll
            for (int m = 0; m < 4; ++m) rwv[ai][m] = rwp[ai * HALF + m * 16] * (YD_FP8 ? 64.0f : 1.0f);
#pragma unroll
        for (int ai = 0; ai < 2; ++ai)
#pragma unroll
            for (int m = 0; m < 4; ++m) { const size_t row = (size_t)(row0 + ai * HALF + m * 16); const float rw = rwv[ai][m];
#pragma unroll
                for (int bj = 0; bj < 2; ++bj) { const f32x4 v0 = (acc[ai][bj][m][0] * sc + bv[bj][0]) * rw, v1 = (acc[ai][bj][m][1] * sc + bv[bj][1]) * rw;
#if YD_FP8
                    u32x2 w8; w8.x = pk4_fp8(v0[0], v0[1], v0[2], v0[3]); w8.y = pk4_fp8(v1[0], v1[1], v1[2], v1[3]);
                    *(u32x2*)((unsigned char*)YD + row * 2048 + col0 + bj * HALF) = w8; } }
#else
                    u32x4 w; w.x = pk2(v0[0], v0[1]); w.y = pk2(v0[2], v0[3]); w.z = pk2(v1[0], v1[1]); w.w = pk2(v1[2], v1[3]);
                    *(u32x4*)(YD + row * 2048 + col0 + bj * HALF) = w; } }
#endif
    }
};
struct GroupedOrder {
    int nM, nN, nwg, G, c; const int* blk_e; bool degen = false;
    __device__ void init(int NB, int nN_, int G_, int c_, const int* be) { nM = NB; nN = nN_; nwg = nM * nN; G = G_; c = c_; blk_e = be; }
    __device__ bool next(int i, Unit& u) const {
        const long L = (long)i * G + c; if (L >= nwg) return false;
        int wgid = (int)L; { const int q = nwg / NXCD, r = nwg % NXCD, xcd = wgid % NXCD, off = wgid / NXCD; wgid = (xcd < r ? xcd * (q + 1) : r * (q + 1) + (xcd - r) * q) + off; }
        const int nig = WGM * nN, gid = wgid / nig, fm = gid * WGM, gsz = (nM - fm) < WGM ? (nM - fm) : WGM;
        u.pm = fm + ((wgid % nig) % gsz); u.pn = (wgid % nig) / gsz; if (degen) { u.pm = 0; u.pn = 0; } u.e = __builtin_amdgcn_readfirstlane(blk_e[u.pm]); return true;
    }
    __device__ __forceinline__ void a_ready(const Unit&) const {}
    __device__ __forceinline__ void done(const Unit&) const {}
};
}

__device__ __forceinline__ void tr_item(const float* W, int N, int K, int k0, int n0, bf16* dst, int drow0, LAS float* scr, int lane) {
    const float* src = W + (size_t)k0 * N + n0 + lane;
#pragma unroll
    for (int i = 0; i < 64; ++i) scr[i * 65 + lane] = __builtin_nontemporal_load(src + (size_t)i * N);
    asm volatile("s_waitcnt lgkmcnt(0)" ::: "memory");
    const int c = lane & 7;
#pragma unroll
    for (int p = 0; p < 8; ++p) { const int n = (lane >> 3) + 8 * p; const LAS float* s = scr + (8 * c) * 65 + n;
        u32x4 o; o.x = pk2(s[0 * 65], s[1 * 65]); o.y = pk2(s[2 * 65], s[3 * 65]); o.z = pk2(s[4 * 65], s[5 * 65]); o.w = pk2(s[6 * 65], s[7 * 65]);
        *(u32x4*)(dst + (size_t)(drow0 + n) * K + k0 + 8 * c) = o; }
    asm volatile("s_waitcnt lgkmcnt(0)" ::: "memory");
}
__device__ __forceinline__ void tr_item8(const float* W, int N, int K, int k0, int n0, unsigned char* dst, int drow0, float scale, LAS float* scr, int lane) {
    const float* src = W + (size_t)k0 * N + n0 + lane;
#pragma unroll
    for (int i = 0; i < 64; ++i) scr[i * 65 + lane] = __builtin_nontemporal_load(src + (size_t)i * N);
    asm volatile("s_waitcnt lgkmcnt(0)" ::: "memory");
    const int c = lane & 3;
#pragma unroll
    for (int p = 0; p < 4; ++p) { const int n = (lane >> 2) + 16 * p; const LAS float* s = scr + (16 * c) * 65 + n;
        u32x4 o; o.x = pk4_fp8(s[0 * 65] * scale, s[1 * 65] * scale, s[2 * 65] * scale, s[3 * 65] * scale); o.y = pk4_fp8(s[4 * 65] * scale, s[5 * 65] * scale, s[6 * 65] * scale, s[7 * 65] * scale);
        o.z = pk4_fp8(s[8 * 65] * scale, s[9 * 65] * scale, s[10 * 65] * scale, s[11 * 65] * scale); o.w = pk4_fp8(s[12 * 65] * scale, s[13 * 65] * scale, s[14 * 65] * scale, s[15 * 65] * scale);
        __builtin_nontemporal_store(o, (u32x4*)(dst + (size_t)(drow0 + n) * K + k0 + 16 * c)); }
    asm volatile("s_waitcnt lgkmcnt(0)" ::: "memory");
}
__device__ __forceinline__ void tr_item8b(const float* W, int N, int K, int k0, int n0, unsigned char* dst, int drow0, float scale, LAS unsigned* scr, int lane) {
#pragma unroll
    for (int half = 0; half < 2; ++half) {
        const float* src = W + (size_t)(k0 + 64 * half) * N + n0 + lane;
        float v[64];
#pragma unroll
        for (int r = 0; r < 64; ++r) v[r] = __builtin_nontemporal_load(src + (size_t)r * N);
#pragma unroll
        for (int rp = 0; rp < 32; ++rp) scr[(32 * half + rp) * 65 + lane] = pk2(v[2 * rp], v[2 * rp + 1]);
    }
    asm volatile("s_waitcnt lgkmcnt(0)" ::: "memory");
    const int c = lane & 7;
#pragma unroll
    for (int p = 0; p < 8; ++p) { const int n = (lane >> 3) + 8 * p; const LAS unsigned* s = scr + (8 * c) * 65 + n;
        u32x4 o;
        { const unsigned a = s[0 * 65], b = s[1 * 65]; o.x = pk4_fp8(bflo(a) * scale, bfhi(a) * scale, bflo(b) * scale, bfhi(b) * scale); }
        { const unsigned a = s[2 * 65], b = s[3 * 65]; o.y = pk4_fp8(bflo(a) * scale, bfhi(a) * scale, bflo(b) * scale, bfhi(b) * scale); }
        { const unsigned a = s[4 * 65], b = s[5 * 65]; o.z = pk4_fp8(bflo(a) * scale, bfhi(a) * scale, bflo(b) * scale, bfhi(b) * scale); }
        { const unsigned a = s[6 * 65], b = s[7 * 65]; o.w = pk4_fp8(bflo(a) * scale, bfhi(a) * scale, bflo(b) * scale, bfhi(b) * scale); }
        __builtin_nontemporal_store(o, (u32x4*)(dst + (size_t)(drow0 + n) * K + k0 + 16 * c)); }
    asm volatile("s_waitcnt lgkmcnt(0)" ::: "memory");
}
__device__ __forceinline__ void tr_item8c(const float* W, int N, int K, int k0, int n0, unsigned char* dst, int drow0, float scale, LAS unsigned* scr, int lane, bool tiled = false) {
    const float* src = W + (size_t)k0 * N + n0 + lane;
    float va[64], vb[64];
#pragma unroll
    for (int r = 0; r < 64; ++r) va[r] = __builtin_nontemporal_load(src + (size_t)r * N);
#pragma unroll
    for (int r = 0; r < 64; ++r) vb[r] = __builtin_nontemporal_load(src + (size_t)(64 + r) * N);
#pragma unroll
    for (int rq = 0; rq < 16; ++rq) scr[(0 + rq) * 65 + lane] = pk4_fp8(va[4 * rq] * scale, va[4 * rq + 1] * scale, va[4 * rq + 2] * scale, va[4 * rq + 3] * scale);
#pragma unroll
    for (int r = 0; r < 64; ++r) va[r] = __builtin_nontemporal_load(src + (size_t)(128 + r) * N);
#pragma unroll
    for (int rq = 0; rq < 16; ++rq) scr[(16 + rq) * 65 + lane] = pk4_fp8(vb[4 * rq] * scale, vb[4 * rq + 1] * scale, vb[4 * rq + 2] * scale, vb[4 * rq + 3] * scale);
#pragma unroll
    for (int r = 0; r < 64; ++r) vb[r] = __builtin_nontemporal_load(src + (size_t)(192 + r) * N);
#pragma unroll
    for (int rq = 0; rq < 16; ++rq) scr[(32 + rq) * 65 + lane] = pk4_fp8(va[4 * rq] * scale, va[4 * rq + 1] * scale, va[4 * rq + 2] * scale, va[4 * rq + 3] * scale);
#pragma unroll
    for (int rq = 0; rq < 16; ++rq) scr[(48 + rq) * 65 + lane] = pk4_fp8(vb[4 * rq] * scale, vb[4 * rq + 1] * scale, vb[4 * rq + 2] * scale, vb[4 * rq + 3] * scale);
    asm volatile("s_waitcnt lgkmcnt(0)" ::: "memory");
    const int c = lane & 15;
#pragma unroll
    for (int p = 0; p < 16; ++p) { const int n = (lane >> 4) + 4 * p; const LAS unsigned* s = scr + (4 * c) * 65 + n;
        u32x4 o; o.x = s[0]; o.y = s[65]; o.z = s[130]; o.w = s[195];
        if (tiled) {
            const int drow = drow0 + n, pn = drow >> 8, hf = (drow >> 7) & 1, rb = drow & 127, x = rb & 31, R = (rb & ~31) + ((((x >> 2) & 1) << 4) + ((x >> 3) << 2) + (x & 3));
            const int kbyte = k0 + 16 * c, kt = kbyte >> 7, C = (kbyte & 127) >> 1;
            __builtin_nontemporal_store(o, (u32x4*)(dst + (((size_t)(pn * (K >> 7) + kt) * 2 + hf) * 16384) + pg8::lds_byte(R, C)));
        } else __builtin_nontemporal_store(o, (u32x4*)(dst + (size_t)(drow0 + n) * K + k0 + 16 * c)); }
    asm volatile("s_waitcnt lgkmcnt(0)" ::: "memory");
}
__device__ __forceinline__ void cvt_item(const float* W, int N, int k0, int n0, bf16* dst, int Nd, int nd0, int lane) {
    const float* src = W + (size_t)k0 * N + n0 + 4 * lane;
    f32x4 v[32];
#pragma unroll
    for (int i = 0; i < 32; ++i) v[i] = *(const f32x4*)(src + (size_t)i * N);
#pragma unroll
    for (int kg = 0; kg < 4; ++kg) {
        u32x4* d = (u32x4*)(dst + ((size_t)((k0 >> 3) + kg) * Nd + nd0) * 8);
#pragma unroll
        for (int q = 0; q < 4; ++q) { u32x4 o; o.x = pk2(v[8 * kg + 0][q], v[8 * kg + 1][q]); o.y = pk2(v[8 * kg + 2][q], v[8 * kg + 3][q]); o.z = pk2(v[8 * kg + 4][q], v[8 * kg + 5][q]); o.w = pk2(v[8 * kg + 6][q], v[8 * kg + 7][q]); d[q] = o; }
    }
}
__device__ __forceinline__ void cvt_rm_item(const float* W, int N, int K, int k0, int n0, bf16* dst, int nd0, int lane) {
    const float* src = W + (size_t)k0 * N + n0 + 4 * lane;
    f32x4 v[32];
#pragma unroll
    for (int i = 0; i < 32; ++i) v[i] = *(const f32x4*)(src + (size_t)i * N);
#pragma unroll
    for (int q = 0; q < 4; ++q) { u32x4* d = (u32x4*)(dst + (size_t)(nd0 + q) * K + k0);
#pragma unroll
        for (int kg = 0; kg < 4; ++kg) { u32x4 o; o.x = pk2(v[8 * kg + 0][q], v[8 * kg + 1][q]); o.y = pk2(v[8 * kg + 2][q], v[8 * kg + 3][q]); o.z = pk2(v[8 * kg + 4][q], v[8 * kg + 5][q]); o.w = pk2(v[8 * kg + 6][q], v[8 * kg + 7][q]); d[kg] = o; } }
}
constexpr int MOE_ITEMS = 32 * 64 * 16 + 32 * 64 * 8;
__device__ __forceinline__ void moe_cvt_item(Frame& F, int it) {
    if (it < 32768) { const int e = it >> 10, q = it & 1023, kb = q >> 4, nb = q & 15, n = nb * 256 + 4 * F.lane;
        cvt_rm_item(F.in[22] + (size_t)e * 2048 * 4096, 4096, 2048, kb * 32, nb * 256, WSP(bf16, WS_WGU) + (size_t)e * 4096 * 2048, 256 * ((n & 2047) >> 7) + 128 * (n >> 11) + (n & 127), F.lane); }
    else { const int r = it - 32768, e = r >> 9, q = r & 511, kb = q >> 3, nb = q & 7;
        cvt_rm_item(F.in[24] + (size_t)e * 2048 * 2048, 2048, 2048, kb * 32, nb * 256, WSP(bf16, WS_WDN) + (size_t)e * 2048 * 2048, nb * 256 + 4 * F.lane, F.lane); }
}
constexpr int CVT_ITEMS = 32 * 16 * 128 + 32 * 16 * 64, CVT_NSW = 4;
struct CvtItem { const float* src; unsigned char* dst; int N, k0, drow0; };
__device__ __forceinline__ bool cvt_decode(Frame& F, int it, CvtItem& I) {
    constexpr int S_GU = 32 * 16 * 128, S_DN = 32 * 16 * 64;
    if (it >= S_GU + S_DN) return false;
    if (it < S_GU) { const int e = it >> 11, q = it & 2047, kb = q >> 7, nb = q & 127, n0 = nb * 32;
        I.N = 4096; I.k0 = kb * 128; I.src = F.in[22] + (size_t)e * 2048 * 4096 + (size_t)I.k0 * 4096 + n0; I.dst = WSP(unsigned char, WS_WGU) + (size_t)e * 4096 * 2048;
        I.drow0 = 256 * ((n0 % 2048) / 128) + 128 * (n0 / 2048) + (n0 % 128);
    } else { const int r = it - S_GU, e = r >> 10, q = r & 1023, kb = q >> 6, nb = q & 63, n0 = nb * 32;
        I.N = 2048; I.k0 = kb * 128; I.src = F.in[24] + (size_t)e * 2048 * 2048 + (size_t)I.k0 * 2048 + n0; I.dst = WSP(unsigned char, WS_WDN) + (size_t)e * 2048 * 2048; I.drow0 = n0; }
    return true;
}
__device__ __forceinline__ void moe_cvt_quota(Frame& F, int quota) {
#if MOE_FP8
    if (F.wave >= 4 || quota <= 0) return;
    LAS unsigned char* lbuf = F.lds + F.wave * 33280;
    unsigned* qctr = (unsigned*)(F.ws + WS_CTL) + CW_Q;
    const int lane = F.lane;
#define CVT_TICKET() ((lane == 0) ? (int)__hip_atomic_fetch_add(qctr, 1u, __ATOMIC_RELAXED, __HIP_MEMORY_SCOPE_AGENT) : 0)
#define CVT_DMA(IT, b) do { const char* _s = (const char*)((IT).src) + (size_t)(lane >> 3) * (size_t)((IT).N * 4) + (lane & 7) * 16; _Pragma("unroll") for (int i = 0; i < 16; ++i) \
        __builtin_amdgcn_global_load_lds((const unsigned*)(_s + (size_t)i * (size_t)((IT).N * 32)), (LAS unsigned*)(lbuf + (b) * 16640 + i * 1040), 16, 0, 2); } while (0)
#define CVT_READ(b) do { const int c8 = lane & 7; const LAS unsigned char* lf = lbuf + (b) * 16640 + (2 * c8) * 1040; \
        _Pragma("unroll") for (int q = 0; q < 4; ++q) { const LAS unsigned char* s = lf + ((lane >> 3) + 8 * q) * 4; _Pragma("unroll") for (int t = 0; t < 16; ++t) fv[q][t] = *(const LAS float*)(s + (t >> 3) * 1040 + (t & 7) * 128); } \
        asm volatile("s_waitcnt lgkmcnt(0)" ::: "memory"); } while (0)
#define CVT_EMIT(C) do { const int c8 = lane & 7; \
        _Pragma("unroll") for (int q = 0; q < 4; ++q) { const int nn = (lane >> 3) + 8 * q; \
            u32x4 o; \
            o.x = pk4_fp8(fv[q][0] * 512.0f, fv[q][1] * 512.0f, fv[q][2] * 512.0f, fv[q][3] * 512.0f); o.y = pk4_fp8(fv[q][4] * 512.0f, fv[q][5] * 512.0f, fv[q][6] * 512.0f, fv[q][7] * 512.0f); \
            o.z = pk4_fp8(fv[q][8] * 512.0f, fv[q][9] * 512.0f, fv[q][10] * 512.0f, fv[q][11] * 512.0f); o.w = pk4_fp8(fv[q][12] * 512.0f, fv[q][13] * 512.0f, fv[q][14] * 512.0f, fv[q][15] * 512.0f); \
            const int drow = (C).drow0 + nn, pn = drow >> 8, hf = (drow >> 7) & 1, rb = drow & 127, x = rb & 31, R = (rb & ~31) + ((((x >> 2) & 1) << 4) + ((x >> 3) << 2) + (x & 3)); \
            __builtin_nontemporal_store(o, (u32x4*)((C).dst + (((size_t)(pn * 16 + ((C).k0 >> 7)) * 2 + hf) * 16384) + pg8::lds_byte(R, 8 * c8))); } } while (0)
    CvtItem A, B, Cur;
    float fv[4][16];
    const int sw = F.bx * 4 + F.wave, SW = F.G * 4;
    int cnt = 0;
    bool va = cvt_decode(F, sw, A); if (!va) return;
    CVT_DMA(A, 0); ++cnt;
    bool vb = false;
    if (cnt < quota) { vb = cvt_decode(F, sw + cnt * SW, B); if (vb) CVT_DMA(B, 1); ++cnt; }
    if (vb) asm volatile("s_waitcnt vmcnt(16)" ::: "memory"); else asm volatile("s_waitcnt vmcnt(0)" ::: "memory");
    for (;;) {
        CVT_READ(0); Cur = A;
        va = false; if (vb && cnt < quota) { va = cvt_decode(F, sw + cnt * SW, A); if (va) CVT_DMA(A, 0); ++cnt; }
        CVT_EMIT(Cur);
        if (!vb) break;
        if (va) asm volatile("s_waitcnt vmcnt(20)" ::: "memory"); else asm volatile("s_waitcnt vmcnt(4)" ::: "memory");
        CVT_READ(1); Cur = B;
        vb = false; if (va && cnt < quota) { vb = cvt_decode(F, sw + cnt * SW, B); if (vb) CVT_DMA(B, 1); ++cnt; }
        CVT_EMIT(Cur);
        if (!va) break;
        if (vb) asm volatile("s_waitcnt vmcnt(20)" ::: "memory"); else asm volatile("s_waitcnt vmcnt(4)" ::: "memory");
    }
#undef CVT_READ
#undef CVT_EMIT
    asm volatile("s_waitcnt vmcnt(0)" ::: "memory");
#undef CVT_TICKET
#undef CVT_DMA
#endif
}
__device__ __forceinline__ void p0_prologue(Frame& F) {
    for (int cb = F.bx; cb < 256; cb += F.G) {
        const int col4 = F.lane % 12, rs = F.lane / 12; const bool act = F.lane < 60;
        const float* cvec = F.in[1]; const float* aw = F.in[2] + cb * 48 + col4 * 4;
        f32x4 acc = {0.f, 0.f, 0.f, 0.f};
        const int r0 = F.wave * 256;
#pragma unroll 13
        for (int i = 0; i < 52; ++i) { const bool ok = act && (i * 5 + rs) < 256; const int rr = ok ? r0 + i * 5 + rs : r0;
            const f32x4 w = *(const f32x4*)(aw + (size_t)rr * 12288); const float cv = cvec[rr];
            acc += w * (ok ? cv * sigmoidf_(cv) : 0.f); }
        LAS f32x4* red = (LAS f32x4*)(F.lds + 135168);
        __syncthreads();
        red[F.wave * 64 + F.lane] = acc;
        __syncthreads();
        if (F.tid < 12) { f32x4 s = *(const f32x4*)(F.in[3] + cb * 48 + F.tid * 4);
            for (int w = 0; w < 8; ++w)
#pragma unroll
                for (int q = 0; q < 5; ++q) s += red[w * 64 + q * 12 + F.tid];
            *(f32x4*)(WSP(float, WS_MOD) + cb * 48 + F.tid * 4) = s; }
    }
    LAS float* scr = (LAS float*)(F.lds + F.wave * 16640);
    const int gw = F.bx * NWAVES + F.wave, NGW = F.G * NWAVES;
    constexpr int I_IN = 32 * 144, I_AU = 16 * 32, I_RU = 16 * 32, I_OUT = 32 * 32, I_RG = 16 * 4;
    constexpr int NITEMS = I_IN + I_AU + I_RU + I_OUT + I_RG;
    for (int it = gw; it < NITEMS; it += NGW) {
        int r = it;
        if (r < I_IN) { const int kb = r / 144, nb = r % 144, n0 = nb * 64;
#if INPROJ_FP8
            if (n0 >= 2048 && n0 < 3072) tr_item8(F.in[5], INW, 2048, kb * 64, n0, WSP(unsigned char, WS_WV), n0 - 2048, 512.0f, scr, F.lane);
            else tr_item8(F.in[5], INW, 2048, kb * 64, n0, WSP(unsigned char, WS_WIN), n0 < 2048 ? n0 : n0 - 1024, 512.0f, scr, F.lane);
#else
            if (n0 >= 2048 && n0 < 3072) tr_item(F.in[5], INW, 2048, kb * 64, n0, WSP(bf16, WS_WV), n0 - 2048, scr, F.lane);
            else tr_item(F.in[5], INW, 2048, kb * 64, n0, WSP(bf16, WS_WIN), n0 < 2048 ? n0 : n0 - 1024, scr, F.lane);
#endif
            continue; } r -= I_IN;
        if (r < I_AU) { const int kb = r / 32, nb = r % 32; if (MIX_FP8) tr_item8(F.in[16], 2048, 1024, kb * 64, nb * 64, WSP(unsigned char, WS_WAU), nb * 64, 512.0f, scr, F.lane); else tr_item(F.in[16], 2048, 1024, kb * 64, nb * 64, WSP(bf16, WS_WAU), nb * 64, scr, F.lane); continue; } r -= I_AU;
        if (r < I_RU) { const int kb = r / 32, nb = r % 32; if (MIX_FP8) tr_item8(F.in[17], 2048, 1024, kb * 64, nb * 64, WSP(unsigned char, WS_WRU), nb * 64, 512.0f, scr, F.lane); else tr_item(F.in[17], 2048, 1024, kb * 64, nb * 64, WSP(bf16, WS_WRU), nb * 64, scr, F.lane); continue; } r -= I_RU;
        if (r < I_OUT) { const int kb = r / 32, nb = r % 32; if (MIX_FP8) tr_item8(F.in[18], 2048, 2048, kb * 64, nb * 64, WSP(unsigned char, WS_WOUT), nb * 64, 512.0f, scr, F.lane); else tr_item(F.in[18], 2048, 2048, kb * 64, nb * 64, WSP(bf16, WS_WOUT), nb * 64, scr, F.lane); continue; } r -= I_OUT;
        { const int which = r / 32, q = r % 32, b = q / 4, kb = (q % 4) / 2, nb = q % 2;
          tr_item(F.in[which ? 13 : 11] + (size_t)b * 16384, 128, 128, kb * 64, nb * 64, WSP(bf16, which ? WS_WXT : WS_WAT) + (size_t)b * 16384, nb * 64, scr, F.lane); }
    }
    {
#if MOE_FP8
#else
        constexpr int I_GU = 32 * 32 * 64, I_DN = 32 * 32 * 32;
        for (int it = gw; it < I_GU + I_DN; it += NGW) {
            if (it < I_GU) { const int e = it / 2048, q = it % 2048, kb = q / 64, nb = q % 64, n0 = nb * 64;
                const int drow0 = 256 * ((n0 % 2048) / 128) + 128 * (n0 / 2048) + (n0 % 128);
                tr_item(F.in[22] + (size_t)e * 2048 * 4096, 4096, 2048, kb * 64, n0, WSP(bf16, WS_WGU) + (size_t)e * 4096 * 2048, drow0, scr, F.lane);
            } else { const int r = it - I_GU, e = r / 1024, q = r % 1024, kb = q / 32, nb = q % 32;
                tr_item(F.in[24] + (size_t)e * 2048 * 2048, 2048, 2048, kb * 64, nb * 64, WSP(bf16, WS_WDN) + (size_t)e * 2048 * 2048, nb * 64, scr, F.lane); }
        }
#endif
    }
}

__device__ __forceinline__ void norm_rows(Frame& F, const float* src, const float* gain, int off_sh, int off_sc, bf16* dstb) {
    const float* mod = WSP(float, WS_MOD);
    f32x4 mul[8], add[8];
#pragma unroll
    for (int j = 0; j < 8; ++j) { const int col = 4 * F.lane + 256 * j; const f32x4 g = *(const f32x4*)(gain + col), sc = *(const f32x4*)(mod + off_sc + col); mul[j] = g * (sc + 1.0f); add[j] = *(const f32x4*)(mod + off_sh + col); }
    const int gw = F.bx * NWAVES + F.wave, NGW = F.G * NWAVES;
    for (int m0 = gw; m0 < T_; m0 += 2 * NGW) {
        const int m1 = (m0 + NGW < T_) ? m0 + NGW : m0;
        const f32x4* xr0 = (const f32x4*)(src + (size_t)m0 * D_) + F.lane; const f32x4* xr1 = (const f32x4*)(src + (size_t)m1 * D_) + F.lane;
        f32x4 v0[8], v1[8]; float s0 = 0.f, s1 = 0.f;
#pragma unroll
        for (int j = 0; j < 8; ++j) { v0[j] = xr0[64 * j]; v1[j] = xr1[64 * j]; }
#pragma unroll
        for (int j = 0; j < 8; ++j) { s0 += (v0[j].x * v0[j].x + v0[j].y * v0[j].y) + (v0[j].z * v0[j].z + v0[j].w * v0[j].w); s1 += (v1[j].x * v1[j].x + v1[j].y * v1[j].y) + (v1[j].z * v1[j].z + v1[j].w * v1[j].w); }
        const float r0 = rsqrtf(wave_sum(s0) * (1.0f / D_) + EPS_), r1 = rsqrtf(wave_sum(s1) * (1.0f / D_) + EPS_);
#pragma unroll
        for (int j = 0; j < 8; ++j) { const f32x4 y0 = v0[j] * r0 * mul[j] + add[j], y1 = v1[j] * r1 * mul[j] + add[j];
#if INPROJ_FP8
            ((unsigned*)((unsigned char*)dstb + (size_t)m0 * D_))[F.lane + 64 * j] = pk4_fp8(y0.x * 16.0f, y0.y * 16.0f, y0.z * 16.0f, y0.w * 16.0f);
            ((unsigned*)((unsigned char*)dstb + (size_t)m1 * D_))[F.lane + 64 * j] = pk4_fp8(y1.x * 16.0f, y1.y * 16.0f, y1.z * 16.0f, y1.w * 16.0f);
#else
            u32x2 w; w.x = pk2(y0.x, y0.y); w.y = pk2(y0.z, y0.w); ((u32x2*)(dstb + (size_t)m0 * D_) + F.lane)[64 * j] = w;
            w.x = pk2(y1.x, y1.y); w.y = pk2(y1.z, y1.w); ((u32x2*)(dstb + (size_t)m1 * D_) + F.lane)[64 * j] = w;
#endif
        }
    }
}

__device__ __forceinline__ void p3_rglru_local(Frame& F) {
    LAS float* XCF = (LAS float*)(F.lds);
    LAS bf16* XCB = (LAS bf16*)(F.lds + 32768);
    LAS float* AA = (LAS float*)(F.lds + 50176);
    LAS float* UU = (LAS float*)(F.lds + 82944);
    LAS float* PART = (LAS float*)(F.lds + 115712);
    const bf16* P8 = WSP(bf16, WS_P8);
    const float* convw = F.in[9]; const float* convb = F.in[10];
    const int tid = F.tid, lane = F.lane, wave = F.wave;
    LAS float* CARRY = (LAS float*)(F.lds + 115712 + 4096);
    for (int su = F.bx; su < 256; su += F.G)
    for (int i8 = 0; i8 < 8; ++i8) {
        const int s = (su >> 3) * 8 + i8, b = su & 7, t0 = s * SEG, ch0 = b * 128;
        if (i8 == 0 && tid < 128) { CARRY[tid * 2] = 0.f; CARRY[tid * 2 + 1] = 1.f; }
        {
            const int cg = tid & 15, tt = tid >> 4;
            float cw[4][8], cb[8];
#pragma unroll
            for (int w = 0; w < 4; ++w) { const f32x4 a = *(const f32x4*)(convw + w * RW + ch0 + 8 * cg), c = *(const f32x4*)(convw + w * RW + ch0 + 8 * cg + 4);
                cw[w][0] = a.x; cw[w][1] = a.y; cw[w][2] = a.z; cw[w][3] = a.w; cw[w][4] = c.x; cw[w][5] = c.y; cw[w][6] = c.z; cw[w][7] = c.w; }
            { const f32x4 a = *(const f32x4*)(convb + ch0 + 8 * cg), c = *(const f32x4*)(convb + ch0 + 8 * cg + 4); cb[0] = a.x; cb[1] = a.y; cb[2] = a.z; cb[3] = a.w; cb[4] = c.x; cb[5] = c.y; cb[6] = c.z; cb[7] = c.w; }
#pragma unroll
            for (int pass = 0; pass < 2; ++pass) {
                const int t = tt + 32 * pass, ta = t0 + t;
                float xc[8];
#pragma unroll
                for (int j = 0; j < 8; ++j) xc[j] = cb[j];
#pragma unroll
                for (int w = 0; w < 4; ++w) { const int row = ta - 3 + w;
                    if (row >= 0) { const u32x4 xv = *(const u32x4*)(P8 + (size_t)row * PW + PRX + ch0 + 8 * cg);
                        xc[0] += cw[w][0] * bflo(xv.x); xc[1] += cw[w][1] * bfhi(xv.x); xc[2] += cw[w][2] * bflo(xv.y); xc[3] += cw[w][3] * bfhi(xv.y);
                        xc[4] += cw[w][4] * bflo(xv.z); xc[5] += cw[w][5] * bfhi(xv.z); xc[6] += cw[w][6] * bflo(xv.w); xc[7] += cw[w][7] * bfhi(xv.w); } }
                *(LAS f32x4*)(XCF + t * 128 + 8 * cg) = (f32x4){xc[0], xc[1], xc[2], xc[3]};
                *(LAS f32x4*)(XCF + t * 128 + 8 * cg + 4) = (f32x4){xc[4], xc[5], xc[6], xc[7]};
                u32x4 w4; w4.x = pk2(xc[0], xc[1]); w4.y = pk2(xc[2], xc[3]); w4.z = pk2(xc[4], xc[5]); w4.w = pk2(xc[6], xc[7]);
                *(LAS u32x4*)(XCB + t * 136 + 8 * cg) = w4;
            }
        }
        __syncthreads();
        {
            const int r = lane & 31, h = lane >> 5, tt2 = wave >> 2, jt = wave & 3;
            f32x16 accA, accX;
#pragma unroll
            for (int i = 0; i < 16; ++i) { accA[i] = 0.f; accX[i] = 0.f; }
            const bf16* wa = WSP(bf16, WS_WAT) + (size_t)b * 16384 + (32 * jt + r) * 128 + 8 * h;
            const bf16* wx = WSP(bf16, WS_WXT) + (size_t)b * 16384 + (32 * jt + r) * 128 + 8 * h;
#pragma unroll
            for (int ks = 0; ks < 8; ++ks) {
                const bf16x8 a = *(const LAS bf16x8*)(XCB + (32 * tt2 + r) * 136 + 16 * ks + 8 * h);
                const bf16x8 ba = *(const bf16x8*)(wa + 16 * ks), bx = *(const bf16x8*)(wx + 16 * ks);
                accA = __builtin_amdgcn_mfma_f32_32x32x16_bf16(a, ba, accA, 0, 0, 0);
                accX = __builtin_amdgcn_mfma_f32_32x32x16_bf16(a, bx, accX, 0, 0, 0);
            }
            const int j = 32 * jt + r, ch = ch0 + j;
            const float bav = F.in[12][ch], bxv = F.in[14][ch], lam = F.in[15][ch];
            const float sp = (lam > 15.f) ? __expf(-lam) : log1pf(__expf(-lam));
#pragma unroll
            for (int reg = 0; reg < 16; ++reg) { const int t = 32 * tt2 + crow(reg, h);
                const float rr = sigmoidf_(accA[reg] + bav), ii = sigmoidf_(accX[reg] + bxv);
                const float la = -8.0f * rr * sp, a = __expf(la);
                const float x2 = 2.0f * la, em = (x2 > -0.05f) ? -x2 * (1.0f + 0.5f * x2 * (1.0f + 0.33333334f * x2 * (1.0f + 0.25f * x2))) : 1.0f - a * a;
                const float uu = __builtin_amdgcn_sqrtf(em) * (ii * XCF[t * 128 + j]);
                AA[t * 128 + j] = a; UU[t * 128 + j] = uu; }
        }
        __syncthreads();
        {
            const int j = tid & 127, p = tid >> 7;
            float h = 0.f, ac = 1.f;
#pragma unroll
            for (int i = 0; i < 16; ++i) { const int t = 16 * p + i; const float a = AA[t * 128 + j], uu = UU[t * 128 + j]; h = a * h + uu; ac *= a; UU[t * 128 + j] = h; AA[t * 128 + j] = ac; }
            PART[(p * 128 + j) * 2] = ac; PART[(p * 128 + j) * 2 + 1] = h;
            __syncthreads();
            float c = CARRY[j * 2], ap = CARRY[j * 2 + 1];
            for (int q = 0; q < p; ++q) { const float qa = PART[(q * 128 + j) * 2], qh = PART[(q * 128 + j) * 2 + 1]; c = qa * c + qh; ap *= qa; }
            bf16* HL = WSP(bf16, WS_HL); bf16* AC = WSP(bf16, WS_AC);
            float hl = 0.f, acl = 0.f;
#pragma unroll
            for (int i = 0; i < 16; ++i) { const int t = 16 * p + i; hl = UU[t * 128 + j] + AA[t * 128 + j] * c; acl = AA[t * 128 + j] * ap;
                HL[(size_t)(t0 + t) * RW + ch0 + j] = (bf16)(pk2(hl, 0.f) & 0xffffu); AC[(size_t)(t0 + t) * RW + ch0 + j] = (bf16)(pk2(acl, 0.f) & 0xffffu); }
            __syncthreads();
            if (p == 3) { CARRY[j * 2] = hl; CARRY[j * 2 + 1] = acl; if (i8 == 7) { WSP(float, WS_SEGA)[(s >> 3) * RW + ch0 + j] = acl; WSP(float, WS_SEGH)[(s >> 3) * RW + ch0 + j] = hl; } }
        }
        __syncthreads();
    }
}

__device__ __forceinline__ void p4_rglru_fix(Frame& F) {
    const float* SA = WSP(float, WS_SEGA); const float* SH = WSP(float, WS_SEGH);
    const bf16* HL = WSP(bf16, WS_HL); const bf16* AC = WSP(bf16, WS_AC);
    const bf16* P8 = WSP(bf16, WS_P8); bf16* YB = WSP(bf16, WS_YB);
    const int ch = 2 * F.tid;
    for (int s = F.bx; s < NSEG; s += F.G) {
        f32x2 c = {0.f, 0.f};
        const int S = s >> 3;
        for (int j0 = 0; j0 < S; j0 += 16) {
            f32x2 a[16], hh[16];
#pragma unroll
            for (int q = 0; q < 16; ++q) { const int j = (j0 + q < S) ? j0 + q : 0; a[q] = *(const f32x2*)(SA + j * RW + ch); hh[q] = *(const f32x2*)(SH + j * RW + ch); }
#pragma unroll
            for (int q = 0; q < 16; ++q) if (j0 + q < S) c = a[q] * c + hh[q];
        }
#pragma unroll 16
        for (int t = 0; t < SEG; ++t) { const size_t row = (size_t)(s * SEG + t);
            const unsigned hlw = *(const unsigned*)(HL + row * RW + ch), acw = *(const unsigned*)(AC + row * RW + ch);
            const f32x2 hl = {bflo(hlw), bfhi(hlw)}, ac = {bflo(acw), bfhi(acw)};
            const unsigned g = *(const unsigned*)(P8 + row * PW + PRG + ch);
            const f32x2 hh = hl + ac * c;
#if MIX_FP8
            *(unsigned short*)((unsigned char*)YB + row * AW + ch) = (unsigned short)pk4_fp8(32.0f * hh.x * gelu_tanh(bflo(g)), 32.0f * hh.y * gelu_tanh(bfhi(g)), 0.f, 0.f); }
#else
            *(unsigned*)(YB + row * AW + ch) = pk2(hh.x * gelu_tanh(bflo(g)), hh.y * gelu_tanh(bfhi(g))); }
#endif
    }
}

__device__ __forceinline__ void p3_qkprep(Frame& F) {
    const bf16* P8 = WSP(bf16, WS_P8); bf16* QH = WSP(bf16, WS_QH); bf16* KH = WSP(bf16, WS_KH);
    const int hq = F.lane >> 3, d0 = (F.lane & 7) * 16;
    float gq[16], gk[16];
#pragma unroll
    for (int j = 0; j < 16; ++j) { gq[j] = F.in[6][d0 + j] * (0.08838834764831845f * 1.44269504089f); gk[j] = F.in[7][d0 + j]; }
    const int gw = F.bx * NWAVES + F.wave, NGW = F.G * NWAVES;
    for (int t = gw; t < T_; t += NGW) {
#pragma unroll
        for (int which = 0; which < 2; ++which) {
            const bf16* src = P8 + (size_t)t * PW + (which ? PK : PQ) + hq * HD + d0;
            const u32x4 a = *(const u32x4*)src, b = *(const u32x4*)(src + 8);
            float f[16] = {bflo(a.x), bfhi(a.x), bflo(a.y), bfhi(a.y), bflo(a.z), bfhi(a.z), bflo(a.w), bfhi(a.w), bflo(b.x), bfhi(b.x), bflo(b.y), bfhi(b.y), bflo(b.z), bfhi(b.z), bflo(b.w), bfhi(b.w)};
            float ss = 0.f;
#pragma unroll
            for (int j = 0; j < 16; ++j) ss += f[j] * f[j];
            ss += __shfl_xor(ss, 1); ss += __shfl_xor(ss, 2); ss += __shfl_xor(ss, 4);
            const float rs = rsqrtf(ss * (1.0f / HD) + EPS_);
            u32x4 o0, o1;
            if (which == 0) { o0.x = pk2(f[0] * rs * gq[0], f[1] * rs * gq[1]); o0.y = pk2(f[2] * rs * gq[2], f[3] * rs * gq[3]); o0.z = pk2(f[4] * rs * gq[4], f[5] * rs * gq[5]); o0.w = pk2(f[6] * rs * gq[6], f[7] * rs * gq[7]);
                o1.x = pk2(f[8] * rs * gq[8], f[9] * rs * gq[9]); o1.y = pk2(f[10] * rs * gq[10], f[11] * rs * gq[11]); o1.z = pk2(f[12] * rs * gq[12], f[13] * rs * gq[13]); o1.w = pk2(f[14] * rs * gq[14], f[15] * rs * gq[15]); }
            else { o0.x = pk2(f[0] * rs * gk[0], f[1] * rs * gk[1]); o0.y = pk2(f[2] * rs * gk[2], f[3] * rs * gk[3]); o0.z = pk2(f[4] * rs * gk[4], f[5] * rs * gk[5]); o0.w = pk2(f[6] * rs * gk[6], f[7] * rs * gk[7]);
                o1.x = pk2(f[8] * rs * gk[8], f[9] * rs * gk[9]); o1.y = pk2(f[10] * rs * gk[10], f[11] * rs * gk[11]); o1.z = pk2(f[12] * rs * gk[12], f[13] * rs * gk[13]); o1.w = pk2(f[14] * rs * gk[14], f[15] * rs * gk[15]); }
            bf16* dst = (which ? KH : QH) + ((size_t)hq * T_ + t) * HD + d0;
            *(u32x4*)dst = o0; *(u32x4*)(dst + 8) = o1;
        }
    }
}

__device__ __forceinline__ int pi23(int i) { return (i & ~12) | ((i & 4) << 1) | ((i & 8) >> 1); }
__device__ __forceinline__ void p4_attention(Frame& F) {
    constexpr int ST_BYTES = 32768, TAB_OFF = 3 * ST_BYTES;
    LAS float* TAB = (LAS float*)(F.lds + TAB_OFF);
    const bf16* QH = WSP(bf16, WS_QH); const bf16* KH = WSP(bf16, WS_KH); const bf16* VTB = WSP(bf16, WS_VT); bf16* YA = WSP(bf16, WS_YA);
    const int lane = F.lane, r = lane & 31, hh = lane >> 5, w = F.wave;
#define ATT_ISSUE(kc, stage) do { \
        _Pragma("unroll") for (int _i = 0; _i < 2; ++_i) { const int L = (w * 2 + _i) * 64 + lane; const int key = L >> 4, dch = (L & 15) ^ (key & 15); \
            __builtin_amdgcn_global_load_lds((const unsigned*)(KH + ((size_t)hd * T_ + (size_t)(kc) * 64 + key) * HD + dch * 8), (LAS unsigned*)(F.lds + (stage) * ST_BYTES + (w * 2 + _i) * 1024), 16, 0, 0); } \
        _Pragma("unroll") for (int _i = 0; _i < 2; ++_i) { const int L = (w * 2 + _i) * 64 + lane; const int d = L >> 3, kcn = (L & 7) ^ ((d >> 1) & 7); \
            __builtin_amdgcn_global_load_lds((const unsigned*)(VTB + (((size_t)hd * 256 + (kc)) * 128 + d) * 64 + kcn * 8), (LAS unsigned*)(F.lds + (stage) * ST_BYTES + 16384 + (w * 2 + _i) * 1024), 16, 0, 0); } \
    } while (0)
    for (int u = F.bx; u < 512; u += F.G) {
        const int hd = u & 7, g = u >> 3;
        const int kc_first = (4 * g >= 8) ? 4 * g - 8 : 0, kc_last = 4 * g + 3, nsteps = kc_last - kc_first + 1;
        const int cw = 4 * g + (w >> 1), q0 = cw * 64 + (w & 1) * 32;
        for (int i = F.tid; i < 320; i += NWAVES * 64) TAB[i] = F.in[8][hd * 320 + i] * 1.44269504089f;
        bf16x8 Qf[8];
        { const bf16* qrow = QH + ((size_t)hd * T_ + q0 + r) * HD + 8 * hh;
#pragma unroll
          for (int ks = 0; ks < 8; ++ks) Qf[ks] = *(const bf16x8*)(qrow + 16 * ks); }
        ATT_ISSUE(kc_first, 0);
        ATT_ISSUE((nsteps > 1 ? kc_first + 1 : kc_first), 1);
        f32x16 O[4];
#pragma unroll
        for (int db = 0; db < 4; ++db)
#pragma unroll
            for (int i = 0; i < 16; ++i) O[db][i] = 0.f;
        float mrun = -1e30f, lrun = 0.f;
        for (int t = 0; t < nsteps; ++t) {
            const int kc = kc_first + t, stage = t % 3;
            asm volatile("s_waitcnt vmcnt(4)" ::: "memory");
            asm volatile("s_waitcnt lgkmcnt(0)" ::: "memory");
            __builtin_amdgcn_s_barrier();
            asm volatile("" ::: "memory");
            { const int kn = (t + 2 < nsteps) ? kc + 2 : kc_last; const int st2 = (t + 2) % 3; ATT_ISSUE(kn, st2); }
            if (kc <= cw && kc + 8 >= cw) {
                const LAS unsigned char* Kb = F.lds + stage * ST_BYTES; const LAS unsigned char* Vb = Kb + 16384;
                f32x16 S[2], S1[2];
#pragma unroll
                for (int t2 = 0; t2 < 2; ++t2) {
#pragma unroll
                    for (int i = 0; i < 16; ++i) { S[t2][i] = 0.f; S1[t2][i] = 0.f; } }
#pragma unroll
                for (int ks = 0; ks < 8; ks += 2) {
#pragma unroll
                    for (int t2 = 0; t2 < 2; ++t2) { const int key = 32 * t2 + pi23(r);
                        const bf16x8 kf = *(const LAS bf16x8*)(Kb + (key * 16 + ((2 * ks + hh) ^ (key & 15))) * 16), kg = *(const LAS bf16x8*)(Kb + (key * 16 + ((2 * ks + 2 + hh) ^ (key & 15))) * 16);
                        S[t2] = __builtin_amdgcn_mfma_f32_32x32x16_bf16(kf, Qf[ks], S[t2], 0, 0, 0); S1[t2] = __builtin_amdgcn_mfma_f32_32x32x16_bf16(kg, Qf[ks + 1], S1[t2], 0, 0, 0); } }
                float mt = -1e30f;
#pragma unroll
                for (int t2 = 0; t2 < 2; ++t2) {
                    const int dbase = (q0 + r) - (kc * 64 + 32 * t2 + 8 * hh);
#pragma unroll
                    for (int reg = 0; reg < 16; ++reg) { const int kl = (reg & 3) + 4 * ((reg >> 2) & 1) + 16 * (reg >> 3);
                        int dist = dbase - kl; dist = dist < -63 ? -63 : (dist > 256 ? 256 : dist);
                        S[t2][reg] = (S[t2][reg] + S1[t2][reg]) + TAB[dist + 63]; mt = fmaxf(mt, S[t2][reg]); } }
                mt = fmaxf(mt, __shfl_xor(mt, 32));
                const float mn = fmaxf(mrun, mt), alpha = __builtin_amdgcn_exp2f(mrun - mn); mrun = mn;
                float ps = 0.f;
#pragma unroll
                for (int t2 = 0; t2 < 2; ++t2)
#pragma unroll
                    for (int reg = 0; reg < 16; ++reg) { S[t2][reg] = __builtin_amdgcn_exp2f(S[t2][reg] - mn); ps += S[t2][reg]; }
                lrun = lrun * alpha + ps;
                if (__any(alpha != 1.0f)) {
#pragma unroll
                    for (int db = 0; db < 4; ++db)
#pragma unroll
                        for (int i = 0; i < 16; ++i) O[db][i] *= alpha; }
                bf16x8 Pb[2][2];
#pragma unroll
                for (int t2 = 0; t2 < 2; ++t2)
#pragma unroll
                    for (int s2 = 0; s2 < 2; ++s2) { u32x4 pw; pw.x = pk2(S[t2][8 * s2 + 0], S[t2][8 * s2 + 1]); pw.y = pk2(S[t2][8 * s2 + 2], S[t2][8 * s2 + 3]); pw.z = pk2(S[t2][8 * s2 + 4], S[t2][8 * s2 + 5]); pw.w = pk2(S[t2][8 * s2 + 6], S[t2][8 * s2 + 7]); Pb[t2][s2] = __builtin_bit_cast(bf16x8, pw); }
#pragma unroll
                for (int t2 = 0; t2 < 2; ++t2)
#pragma unroll
                    for (int s2 = 0; s2 < 2; ++s2)
#pragma unroll
                        for (int db = 0; db < 4; ++db) { const int d = 32 * db + r;
                            const bf16x8 vf = *(const LAS bf16x8*)(Vb + (d * 8 + ((4 * t2 + 2 * s2 + hh) ^ ((d >> 1) & 7))) * 16);
                            O[db] = __builtin_amdgcn_mfma_f32_32x32x16_bf16(vf, Pb[t2][s2], O[db], 0, 0, 0); }
            }
        }
        lrun += __shfl_xor(lrun, 32);
        const float inv = (MIX_FP8 ? 32.0f : 1.0f) / lrun;
        bf16* orow = YA + (size_t)(q0 + r) * AW + hd * HD + 4 * hh;
#pragma unroll
        for (int db = 0; db < 4; ++db)
#pragma unroll
            for (int gq = 0; gq < 4; ++gq) {
#if MIX_FP8
                *(unsigned*)((unsigned char*)YA + (size_t)(q0 + r) * AW + hd * HD + 4 * hh + 32 * db + 8 * gq) = pk4_fp8(O[db][4 * gq] * inv, O[db][4 * gq + 1] * inv, O[db][4 * gq + 2] * inv, O[db][4 * gq + 3] * inv);
#else
                u32x2 ow; ow.x = pk2(O[db][4 * gq] * inv, O[db][4 * gq + 1] * inv); ow.y = pk2(O[db][4 * gq + 2] * inv, O[db][4 * gq + 3] * inv);
                *(u32x2*)(orow + 32 * db + 8 * gq) = ow;
#endif
            }
        asm volatile("s_waitcnt vmcnt(0) lgkmcnt(0)" ::: "memory");
        __builtin_amdgcn_s_barrier();
        asm volatile("" ::: "memory");
    }
#undef ATT_ISSUE
}

__device__ __forceinline__ void p7_router(Frame& F) {
    LAS float* PARTL = (LAS float*)(F.lds);
    LAS float* LOG = (LAS float*)(F.lds + 65536);
    LAS float* RSTD = (LAS float*)(F.lds + 65536 + 8448);
    LAS int* hist = (LAS int*)(F.lds + 65536 + 8448 + 256);
    const float* mod = WSP(float, WS_MOD); const float* gain = F.in[19];
    const float* WRT = WSP(float, WS_WRT); const float* RB = WSP(float, WS_RB);
    bf16* XN = WSP(bf16, WS_XN); int* TOPE = WSP(int, WS_TOPE); float* TOPW = WSP(float, WS_TOPW);
    const int r = F.lane & 31, kh = F.lane >> 5;
    { int* ROWTOK = WSP(int, WS_ROWTOK);
      for (int i = F.bx * NWAVES * 64 + F.tid; i < NROWS; i += F.G * NWAVES * 64) ROWTOK[i] = T_;
      if (F.bx == 0) ((unsigned*)(WSP(unsigned char, WS_XN) + (size_t)T_ * WPITCH))[F.tid] = 0u; }
    for (int ck = F.bx; ck < 256; ck += F.G) {
        if (F.tid < 32) hist[F.tid] = 0;
        f32x4 mulv[8], addv[8];
#pragma unroll
        for (int j = 0; j < 8; ++j) { const int col = 4 * F.lane + 256 * j; mulv[j] = *(const f32x4*)(gain + col) * (*(const f32x4*)(mod + 8192 + col) + 1.0f); addv[j] = *(const f32x4*)(mod + 6144 + col); }
        for (int i = 0; i < 8; i += 2) {
            const int m0 = ck * 64 + F.wave * 8 + i, m1 = m0 + 1;
            const f32x4* xr0 = (const f32x4*)(F.out + (size_t)m0 * D_) + F.lane; const f32x4* xr1 = (const f32x4*)(F.out + (size_t)m1 * D_) + F.lane;
            f32x4 v0[8], v1[8]; float s0 = 0.f, s1 = 0.f;
#pragma unroll
            for (int j = 0; j < 8; ++j) { v0[j] = xr0[64 * j]; v1[j] = xr1[64 * j]; }
#pragma unroll
            for (int j = 0; j < 8; ++j) { s0 += (v0[j].x * v0[j].x + v0[j].y * v0[j].y) + (v0[j].z * v0[j].z + v0[j].w * v0[j].w); s1 += (v1[j].x * v1[j].x + v1[j].y * v1[j].y) + (v1[j].z * v1[j].z + v1[j].w * v1[j].w); }
            const float r0 = rsqrtf(wave_sum(s0) * (1.0f / D_) + EPS_), r1 = rsqrtf(wave_sum(s1) * (1.0f / D_) + EPS_);
            if (F.lane == 0) { RSTD[F.wave * 8 + i] = r0; RSTD[F.wave * 8 + i + 1] = r1; }
#pragma unroll
            for (int j = 0; j < 8; ++j) { const f32x4 y0 = v0[j] * r0 * mulv[j] + addv[j], y1 = v1[j] * r1 * mulv[j] + addv[j];
#if MOE_FP8
                ((unsigned*)(WSP(unsigned char, WS_XN) + (size_t)m0 * WPITCH))[F.lane + 64 * j] = pk4_fp8(y0.x * 16.0f, y0.y * 16.0f, y0.z * 16.0f, y0.w * 16.0f);
                ((unsigned*)(WSP(unsigned char, WS_XN) + (size_t)m1 * WPITCH))[F.lane + 64 * j] = pk4_fp8(y1.x * 16.0f, y1.y * 16.0f, y1.z * 16.0f, y1.w * 16.0f);
#else
                u32x2 w; w.x = pk2(y0.x, y0.y); w.y = pk2(y0.z, y0.w); ((u32x2*)(XN + (size_t)m0 * D_) + F.lane)[64 * j] = w;
                w.x = pk2(y1.x, y1.y); w.y = pk2(y1.z, y1.w); ((u32x2*)(XN + (size_t)m1 * D_) + F.lane)[64 * j] = w;
#endif
            }
        }
        {
            f32x16 acc0, acc1;
#pragma unroll
            for (int q = 0; q < 16; ++q) { acc0[q] = 0.f; acc1[q] = 0.f; }
            const float* a0p = F.out + (size_t)(ck * 64 + r) * D_ + F.wave * 256 + 4 * kh;
            const float* a1p = a0p + (size_t)32 * D_;
            const float* bp = WRT + (size_t)r * D_ + F.wave * 256 + 4 * kh;
#pragma unroll 4
            for (int g = 0; g < 32; ++g) {
                const f32x4 a0 = *(const f32x4*)(a0p + 8 * g), a1 = *(const f32x4*)(a1p + 8 * g), b = *(const f32x4*)(bp + 8 * g);
#pragma unroll
                for (int q = 0; q < 4; ++q) { acc0 = __builtin_amdgcn_mfma_f32_32x32x2f32(a0[q], b[q], acc0, 0, 0, 0); acc1 = __builtin_amdgcn_mfma_f32_32x32x2f32(a1[q], b[q], acc1, 0, 0, 0); }
            }
#pragma unroll
            for (int reg = 0; reg < 16; ++reg) { const int tok = crow(reg, kh); PARTL[(F.wave * 64 + tok) * 32 + r] = acc0[reg]; PARTL[(F.wave * 64 + 32 + tok) * 32 + r] = acc1[reg]; }
        }
        __syncthreads();
        {
            const int tok = F.tid >> 3, e4 = (F.tid & 7) * 4;
            f32x4 sacc = {0.f, 0.f, 0.f, 0.f};
#pragma unroll
            for (int w = 0; w < 8; ++w) sacc += *(const LAS f32x4*)(PARTL + (w * 64 + tok) * 32 + e4);
            const f32x4 lg = sacc * RSTD[tok] + *(const f32x4*)(RB + e4);
            LOG[tok * 33 + e4] = lg.x; LOG[tok * 33 + e4 + 1] = lg.y; LOG[tok * 33 + e4 + 2] = lg.z; LOG[tok * 33 + e4 + 3] = lg.w;
        }
        __syncthreads();
        {
            const int tok = F.tid >> 3, sub = F.tid & 7, m = ck * 64 + tok;
            float lg[4];
#pragma unroll
            for (int j = 0; j < 4; ++j) lg[j] = LOG[tok * 33 + sub * 4 + j];
            int ti[4]; float tv[4];
#pragma unroll
            for (int k = 0; k < 4; ++k) { float best = lg[0]; int bi = sub * 4;
#pragma unroll
                for (int j = 1; j < 4; ++j) if (lg[j] > best) { best = lg[j]; bi = sub * 4 + j; }
#pragma unroll
                for (int o = 1; o < 8; o <<= 1) { const float ov = __shfl_xor(best, o); const int oi = __shfl_xor(bi, o); if (ov > best || (ov == best && oi < bi)) { best = ov; bi = oi; } }
                ti[k] = bi; tv[k] = best;
#pragma unroll
                for (int j = 0; j < 4; ++j) if (bi == sub * 4 + j) lg[j] = -3.0e38f; }
            if (sub == 0) {
                const float e1 = __expf(tv[1] - tv[0]), e2 = __expf(tv[2] - tv[0]), e3 = __expf(tv[3] - tv[0]); const float inv = 1.0f / (1.0f + e1 + e2 + e3);
                *(int4*)(TOPE + m * 4) = make_int4(ti[0], ti[1], ti[2], ti[3]); *(f32x4*)(TOPW + m * 4) = (f32x4){inv, e1 * inv, e2 * inv, e3 * inv};
                __hip_atomic_fetch_add(&hist[ti[0]], 1, __ATOMIC_RELAXED, __HIP_MEMORY_SCOPE_WORKGROUP); __hip_atomic_fetch_add(&hist[ti[1]], 1, __ATOMIC_RELAXED, __HIP_MEMORY_SCOPE_WORKGROUP);
                __hip_atomic_fetch_add(&hist[ti[2]], 1, __ATOMIC_RELAXED, __HIP_MEMORY_SCOPE_WORKGROUP); __hip_atomic_fetch_add(&hist[ti[3]], 1, __ATOMIC_RELAXED, __HIP_MEMORY_SCOPE_WORKGROUP); }
        }
        __syncthreads();
        if (F.tid < 32) WSP(int, WS_HIST)[ck * 32 + F.tid] = hist[F.tid];
        __syncthreads();
    }
}

__device__ __forceinline__ void p8_place(Frame& F) {
    LAS int* es = (LAS int*)(F.lds);
    LAS int* dsts = es + 256;
    LAS int* cnt = es + 512;
    LAS int* base = es + 544;
    LAS int* pst = es + 576;
    const int* HIST = WSP(int, WS_HIST); const int* TOPE = WSP(int, WS_TOPE); const float* TOPW = WSP(float, WS_TOPW);
    int* POS = WSP(int, WS_POS); float* ROWW = WSP(float, WS_ROWW); int* PLAN = WSP(int, WS_PLAN);
    const bf16* XN = WSP(bf16, WS_XN); bf16* XB = WSP(bf16, WS_XB);
    for (int ck = F.bx; ck < 256; ck += F.G) {
        { LAS int* ptot = es + 640; LAS int* ppre = es + 1152;
          const int e = F.tid & 31, p = F.tid >> 5; int tot = 0, pre = 0;
#pragma unroll
          for (int q = 0; q < 16; ++q) { const int c2 = p * 16 + q; const int v = HIST[c2 * 32 + e]; tot += v; pre += (c2 < ck) ? v : 0; }
          ptot[p * 32 + e] = tot; ppre[p * 32 + e] = pre;
          __syncthreads();
          if (F.tid < 32) { int t = 0, pr = 0;
#pragma unroll
              for (int q = 0; q < 16; ++q) { t += ptot[q * 32 + F.tid]; pr += ppre[q * 32 + F.tid]; }
              cnt[F.tid] = t; base[F.tid] = pr; } }
        __syncthreads();
        if (F.tid == 0) { int ps = 0; for (int e = 0; e < 32; ++e) { pst[e] = ps; const int nb = (cnt[e] + 255) >> 8;
                if (ck == 0) { PLAN[32 + e] = ps; PLAN[64 + e] = cnt[e]; for (int q = 0; q < nb; ++q) PLAN[128 + (ps >> 8) + q] = e; }
                ps += nb << 8; }
            if (ck == 0) PLAN[0] = ps >> 8; }
        if (F.tid < 256) es[F.tid] = TOPE[ck * 256 + F.tid];
        __syncthreads();
        if (F.tid < 256) { const int e = es[F.tid]; int rank = 0; for (int j = 0; j < F.tid; ++j) rank += (es[j] == e) ? 1 : 0;
            const int dest = pst[e] + base[e] + rank; dsts[F.tid] = dest; POS[ck * 256 + F.tid] = dest; ROWW[dest] = TOPW[ck * 256 + F.tid]; WSP(int, WS_ROWTOK)[dest] = ck * 64 + (F.tid >> 2); }
        __syncthreads();
#if !MOE_FP8
        for (int i = F.wave * 32; i < F.wave * 32 + 32; ++i) { const int tok = ck * 64 + (i >> 2), dest = dsts[i];
#if MOE_FP8
            const u32x4* srow = (const u32x4*)((const unsigned char*)XN + (size_t)tok * D_) + F.lane; u32x4* drow = (u32x4*)((unsigned char*)XB + (size_t)dest * D_) + F.lane;
#pragma unroll
            for (int q = 0; q < 2; ++q) drow[64 * q] = srow[64 * q]; }
#else
            const u32x4* srow = (const u32x4*)(XN + (size_t)tok * D_) + F.lane; u32x4* drow = (u32x4*)(XB + (size_t)dest * D_) + F.lane;
#pragma unroll
            for (int q = 0; q < 4; ++q) drow[64 * q] = srow[64 * q]; }
#endif
#endif
        __syncthreads();
    }
}

__device__ __forceinline__ void p11_combine(Frame& F) {
    const float* g2 = WSP(float, WS_MOD) + 10240; const int* POS = WSP(int, WS_POS); const bf16* YD = WSP(bf16, WS_YD);
    f32x4 gv[8];
#pragma unroll
    for (int j = 0; j < 8; ++j) gv[j] = *(const f32x4*)(g2 + 4 * F.lane + 256 * j) * (YD_FP8 ? 0.015625f : 1.0f);
    const int gw = F.bx * NWAVES + F.wave, NGW = F.G * NWAVES;
    for (int m = gw; m < T_; m += NGW) {
        const int4 ps = *(const int4*)(POS + m * 4);
        f32x4* orow = (f32x4*)(F.out + (size_t)m * D_) + F.lane;
#if YD_FP8
        const unsigned* r0 = (const unsigned*)((const unsigned char*)YD + (size_t)ps.x * D_) + F.lane; const unsigned* r1 = (const unsigned*)((const unsigned char*)YD + (size_t)ps.y * D_) + F.lane;
        const unsigned* r2 = (const unsigned*)((const unsigned char*)YD + (size_t)ps.z * D_) + F.lane; const unsigned* r3 = (const unsigned*)((const unsigned char*)YD + (size_t)ps.w * D_) + F.lane;
#pragma unroll
        for (int j = 0; j < 8; ++j) { const int a = (int)r0[64 * j], b = (int)r1[64 * j], c = (int)r2[64 * j], d = (int)r3[64 * j];
            f32x4 y; y.x = ((__builtin_amdgcn_cvt_f32_fp8(a, 0) + __builtin_amdgcn_cvt_f32_fp8(b, 0)) + __builtin_amdgcn_cvt_f32_fp8(c, 0)) + __builtin_amdgcn_cvt_f32_fp8(d, 0);
            y.y = ((__builtin_amdgcn_cvt_f32_fp8(a, 1) + __builtin_amdgcn_cvt_f32_fp8(b, 1)) + __builtin_amdgcn_cvt_f32_fp8(c, 1)) + __builtin_amdgcn_cvt_f32_fp8(d, 1);
            y.z = ((__builtin_amdgcn_cvt_f32_fp8(a, 2) + __builtin_amdgcn_cvt_f32_fp8(b, 2)) + __builtin_amdgcn_cvt_f32_fp8(c, 2)) + __builtin_amdgcn_cvt_f32_fp8(d, 2);
            y.w = ((__builtin_amdgcn_cvt_f32_fp8(a, 3) + __builtin_amdgcn_cvt_f32_fp8(b, 3)) + __builtin_amdgcn_cvt_f32_fp8(c, 3)) + __builtin_amdgcn_cvt_f32_fp8(d, 3);
            orow[64 * j] = orow[64 * j] + gv[j] * y; }
#else
        const u32x2* r0 = (const u32x2*)(YD + (size_t)ps.x * D_) + F.lane; const u32x2* r1 = (const u32x2*)(YD + (size_t)ps.y * D_) + F.lane;
        const u32x2* r2 = (const u32x2*)(YD + (size_t)ps.z * D_) + F.lane; const u32x2* r3 = (const u32x2*)(YD + (size_t)ps.w * D_) + F.lane;
#pragma unroll
        for (int j = 0; j < 8; ++j) { const u32x2 a = r0[64 * j], b = r1[64 * j], c = r2[64 * j], d = r3[64 * j];
            f32x4 y; y.x = ((bflo(a.x) + bflo(b.x)) + bflo(c.x)) + bflo(d.x); y.y = ((bfhi(a.x) + bfhi(b.x)) + bfhi(c.x)) + bfhi(d.x);
            y.z = ((bflo(a.y) + bflo(b.y)) + bflo(c.y)) + bflo(d.y); y.w = ((bfhi(a.y) + bfhi(b.y)) + bfhi(c.y)) + bfhi(d.y);
            orow[64 * j] = orow[64 * j] + gv[j] * y; }
#endif
    }
}

struct Args { const float* in[26]; float* out; unsigned char* ws; int ph_lo, ph_hi; };
__global__ void __launch_bounds__(NWAVES * 64, 2) skel_fwd(Args args) {
    extern __shared__ __attribute__((aligned(16))) unsigned char lds[];
    Frame F;
    F.lds = (LAS unsigned char*)lds;
    F.tid = threadIdx.x; F.lane = F.tid & 63; F.wave = __builtin_amdgcn_readfirstlane(F.tid >> 6);
    F.G = gridDim.x; F.bx = blockIdx.x;
#pragma unroll
    for (int i = 0; i < 26; ++i) F.in[i] = args.in[i];
    F.out = args.out; F.ws = args.ws;
    volatile LAS unsigned* MISC = (volatile LAS unsigned*)(F.lds + MISC_OFF);
    if (F.tid < 64) MISC[F.tid] = 0u;
    __syncthreads();
    XcdBarrier bar; bar.bar = (unsigned*)(F.ws + WS_CTL) + CW_BAR; bar.x = 0; bar.st = nullptr;
    if (MK_ONE_LAUNCH) bar = xcd_barrier_post((unsigned*)(F.ws + WS_CTL) + CW_BAR, MISC + 8);
    F.vbx = F.bx;
    if (MK_ONE_LAUNCH) { if (F.tid == 0) MISC[16] = __hip_atomic_fetch_add((unsigned*)(F.ws + WS_CTL) + CW_RANK + 64 * bar.x, 1u, __ATOMIC_RELAXED, __HIP_MEMORY_SCOPE_AGENT); __syncthreads(); }
    const int lo = args.ph_lo, hi = args.ph_hi;
#define RS_ARGS(k, rounds) ((ROUND_SYNC && MK_ONE_LAUNCH) ? (unsigned*)(F.ws + WS_CTL) + CW_RS + 1024 * (k) + 64 * bar.x : (unsigned*)nullptr), (unsigned)MISC[8], (rounds)
#ifndef PH_MASK
#define PH_MASK 0xfff
#endif
#define IN(k) (((PH_MASK >> (k)) & 1) && lo <= (k) && (k) < hi)
#ifndef REP_MASK
#define REP_MASK 0
#endif
#define REPS(k) for (int rep_ = 0; rep_ < 1 + ((REP_MASK >> (k)) & 1); ++rep_)
#define REPBAR() do { if (rep_) xcd_barrier(bar); } while (0)
#define SEAM(k) do { if (MK_ONE_LAUNCH && IN(k) && IN((k) + 1)) xcd_barrier(bar); } while (0)
    using namespace pg8;
    if (IN(0)) REPS(0) { REPBAR(); p0_prologue(F); } SEAM(0);
#ifndef REAL_XCC
#define REAL_XCC 1
#endif
    if (MK_ONE_LAUNCH && REAL_XCC && lo == 0 && hi > 1) {
        bool ok = (F.G == 256);
        for (int j = 0; j < 16; ++j) { const unsigned cj = __hip_atomic_load(bar.bar + XB_XCNT(j), __ATOMIC_RELAXED, __HIP_MEMORY_SCOPE_AGENT); ok = ok && (cj == (j < 8 ? 32u : 0u)); }
        const unsigned rk = MISC[16];
        if (ok && rk < 32u && bar.x < 8u) F.vbx = (int)(rk * 8u + bar.x);
    }
    if (IN(1)) REPS(1) { REPBAR(); norm_rows(F, F.in[0], F.in[4], 0, 2048, WSP(bf16, WS_XN));
        const int gw = F.bx * NWAVES + F.wave;
        if (gw < NE) { const float* mod = WSP(float, WS_MOD); float bs = 0.f;
            for (int k = F.lane; k < D_; k += 64) { const float w = F.in[20][(size_t)k * NE + gw]; WSP(float, WS_WRT)[(size_t)gw * D_ + k] = w * (F.in[19][k] * (1.0f + mod[8192 + k])); bs += mod[6144 + k] * w; }
            bs = wave_sum(bs); if (F.lane == 0) WSP(float, WS_RB)[gw] = bs + F.in[21][gw]; }
    } SEAM(1);
    if (IN(2)) REPS(2) { REPBAR();
        const int cgrp = (F.bx >> 3) & 1;
#if CVT_HOST == 2
        if (cgrp == 0) { moe_cvt_quota(F, (CVT_ITEMS + F.G * CVT_NSW - 1) / (F.G * CVT_NSW)); __syncthreads(); }
#endif
#if INPROJ_FP8
        { Gemm g{WSP(bf16, WS_XN), WSP(bf16, WS_WIN), T_, PW, D_ / 2, 0, 0, RS_ARGS(0, (T_ / 256) * (PW / 256) / F.G), 0, 0}; StaticOrder S; S.init(T_, PW, F.G, F.vbx); EpiProj E{WSP(bf16, WS_P8), PW, 0.0001220703125f, WSP(bf16, WS_QH), WSP(bf16, WS_KH), F.in[6], F.in[7], (LAS float*)(F.lds + ROWTAB_OFF)};
          gemm_phase<EpiProj, StaticOrder, true, true, false, true>(F.lds, g, S, E); }
        { Gemm g{WSP(bf16, WS_WV), WSP(bf16, WS_XN), AW, T_, D_ / 2, 0, 0, nullptr, 0u, 0, 0, 0}; StaticOrder S; S.init(AW, T_, F.G, F.vbx); EpiVtb E{WSP(bf16, WS_VT), 0.0001220703125f};
          gemm_phase<EpiVtb, StaticOrder, true, true, false, true>(F.lds, g, S, E); }
#if CVT_HOST == 2
        if (cgrp == 1) { __syncthreads(); moe_cvt_quota(F, (CVT_ITEMS + F.G * CVT_NSW - 1) / (F.G * CVT_NSW)); }
#endif
#else
        { Gemm g{WSP(bf16, WS_XN), WSP(bf16, WS_WIN), T_, PW, D_, 0, 0, nullptr, 0u, 0, 0, 0}; StaticOrder S; S.init(T_, PW, F.G, F.vbx); EpiStoreBf16 E{WSP(bf16, WS_P8), PW, 1.0f};
          gemm_phase<EpiStoreBf16, StaticOrder, true, true>(F.lds, g, S, E); }
        { Gemm g{WSP(bf16, WS_WV), WSP(bf16, WS_XN), AW, T_, D_, 0, 0, nullptr, 0u, 0, 0, 0}; StaticOrder S; S.init(AW, T_, F.G, F.vbx); EpiVtb E{WSP(bf16, WS_VT), 1.0f};
          gemm_phase<EpiVtb, StaticOrder, true, true>(F.lds, g, S, E); }
#endif
    } SEAM(2);
    if (IN(3)) REPS(3) { REPBAR(); if (!INPROJ_FP8) p3_qkprep(F); p3_rglru_local(F); } SEAM(3);
    if (IN(4)) REPS(4) { REPBAR();
#ifndef PROBE_P4
#define PROBE_P4 0
#endif
#if CVT_HOST == 4
        if (((F.bx >> 3) & 1) == 0) { moe_cvt_quota(F, (CVT_ITEMS + F.G * CVT_NSW - 1) / (F.G * CVT_NSW)); __syncthreads(); }
#endif
        for (int ps = 0; ps < 2; ++ps) { if ((ps ^ ((F.bx >> 3) & 1)) == 0) { if (!(PROBE_P4 == 2 && rep_ == 0)) p4_rglru_fix(F); } else { if (!(PROBE_P4 == 1 && rep_ == 0)) p4_attention(F); } __syncthreads(); }
#if CVT_HOST == 4
        if (((F.bx >> 3) & 1) == 1) { moe_cvt_quota(F, (CVT_ITEMS + F.G * CVT_NSW - 1) / (F.G * CVT_NSW)); }
#endif
    } SEAM(4);
    if (IN(5)) REPS(5) { REPBAR();
#if MIX_FP8
        { Gemm g{WSP(bf16, WS_YA), WSP(bf16, WS_WAU), T_, D_, AW / 2, 0, 0, nullptr, 0u, 0, 0, 0}; StaticOrder S; S.init(T_, D_, F.G, F.vbx); EpiMerge1 E{WSP(float, WS_T1), WSP(bf16, WS_P8) + PGA, PW, 0.00006103515625f};
          gemm_phase<EpiMerge1, StaticOrder, true, true, false, true>(F.lds, g, S, E); }
        { Gemm g{WSP(bf16, WS_YB), WSP(bf16, WS_WRU), T_, D_, RW / 2, 0, 0, nullptr, 0u, 0, 0, 0}; StaticOrder S; S.init(T_, D_, F.G, F.vbx); EpiMerge2 E{WSP(float, WS_T1), WSP(bf16, WS_P8) + PGB, PW, WSP(bf16, WS_MG), 0.00006103515625f};
          gemm_phase<EpiMerge2, StaticOrder, true, true, false, true>(F.lds, g, S, E); }
#else
        { Gemm g{WSP(bf16, WS_YA), WSP(bf16, WS_WAU), T_, D_, AW, 0, 0, nullptr, 0u, 0, 0, 0}; StaticOrder S; S.init(T_, D_, F.G, F.vbx); EpiMerge1 E{WSP(float, WS_T1), WSP(bf16, WS_P8) + PGA, PW, 1.0f};
          gemm_phase<EpiMerge1, StaticOrder, true, true>(F.lds, g, S, E); }
        { Gemm g{WSP(bf16, WS_YB), WSP(bf16, WS_WRU), T_, D_, RW, 0, 0, nullptr, 0u, 0, 0, 0}; StaticOrder S; S.init(T_, D_, F.G, F.vbx); EpiMerge2 E{WSP(float, WS_T1), WSP(bf16, WS_P8) + PGB, PW, WSP(bf16, WS_MG), 1.0f};
          gemm_phase<EpiMerge2, StaticOrder, true, true>(F.lds, g, S, E); }
#endif
    } SEAM(5);
#if MIX_FP8
    if (IN(6)) REPS(6) { REPBAR(); Gemm g{WSP(bf16, WS_MG), WSP(bf16, WS_WOUT), T_, D_, D_ / 2, 0, 0, nullptr, 0u, 0, 0, 0}; StaticOrder S; S.init(T_, D_, F.G, F.vbx); EpiOut E{F.in[0], WSP(float, WS_MOD) + 4096, F.out, 0.000030517578125f};
        gemm_phase<EpiOut, StaticOrder, true, true, false, true>(F.lds, g, S, E); } SEAM(6);
#else
    if (IN(6)) REPS(6) { REPBAR(); Gemm g{WSP(bf16, WS_MG), WSP(bf16, WS_WOUT), T_, D_, D_, 0, 0, nullptr, 0u, 0, 0, 0}; StaticOrder S; S.init(T_, D_, F.G, F.vbx); EpiOut E{F.in[0], WSP(float, WS_MOD) + 4096, F.out, 1.0f};
        gemm_phase<EpiOut, StaticOrder, true, true>(F.lds, g, S, E); } SEAM(6);
#endif
    if (IN(7)) REPS(7) { REPBAR(); p7_router(F); } SEAM(7);
    if (IN(8)) REPS(8) { REPBAR(); p8_place(F); } SEAM(8);
    if (IN(9)) REPS(9) { REPBAR(); const int* PLAN = WSP(int, WS_PLAN); const int NB = __builtin_amdgcn_readfirstlane(PLAN[0]);
        GroupedOrder S; S.init(NB, 16, F.G, F.vbx, PLAN + 128);
#ifndef PROBE_DEGEN
#define PROBE_DEGEN 0
#endif
        S.degen = PROBE_DEGEN && rep_ == 0 && args.ph_hi == N_PHASES;
#if MOE_FP8
        { const int* ROWTOK = WSP(const int, WS_ROWTOK); LAS int* rowtab = (LAS int*)(F.lds + ROWTAB_OFF);
          for (int i = 0; i < 20; ++i) { Unit u; if (!S.next(i, u)) break; if (F.tid < 256) rowtab[i * 256 + F.tid] = ROWTOK[u.pm * 256 + F.tid]; }
          __syncthreads(); }
        Gemm g{WSP(bf16, WS_XN), WSP(bf16, WS_WGU), NB * 256, 4096, D_ / 2, (size_t)4096 * 2048, ROWTAB_OFF, RS_ARGS(1, NB * 16 / F.G), WPITCH, 0}; EpiSwiGLU8 E{F.in[23], WSP(unsigned char, WS_ACT), F.lds};
        gemm_phase<EpiSwiGLU8, GroupedOrder, true, true, true, true, true>(F.lds, g, S, E);
#else
        Gemm g{WSP(bf16, WS_XB), WSP(bf16, WS_WGU), NB * 256, 4096, D_, (size_t)4096 * 2048 * 2, 0, nullptr, 0u, 0, 0, 0}; EpiSwiGLU E{F.in[23], WSP(bf16, WS_ACT)};
        gemm_phase<EpiSwiGLU, GroupedOrder, true, true>(F.lds, g, S, E);
#endif
    } SEAM(9);
    if (IN(10)) REPS(10) { REPBAR(); const int* PLAN = WSP(int, WS_PLAN); const int NB = __builtin_amdgcn_readfirstlane(PLAN[0]);
        GroupedOrder S; S.init(NB, 8, F.G, F.vbx, PLAN + 128);
#if MOE_FP8
        Gemm g{WSP(bf16, WS_ACT), WSP(bf16, WS_WDN), NB * 256, 2048, DFF / 2, (size_t)2048 * 2048, 0, RS_ARGS(2, NB * 8 / F.G), 0, 0}; EpiDown E{F.in[25], WSP(float, WS_ROWW), WSP(bf16, WS_YD), 0.00048828125f, F.lds};
        gemm_phase<EpiDown, GroupedOrder, true, true, true, true>(F.lds, g, S, E);
#else
        Gemm g{WSP(bf16, WS_ACT), WSP(bf16, WS_WDN), NB * 256, 2048, DFF, (size_t)2048 * 2048 * 2, 0, nullptr, 0u, 0, 0, 0}; EpiDown E{F.in[25], WSP(float, WS_ROWW), WSP(bf16, WS_YD), 1.0f, F.lds};
        gemm_phase<EpiDown, GroupedOrder, true, true>(F.lds, g, S, E);
#endif
    } SEAM(10);
    if (IN(11)) REPS(11) { REPBAR(); p11_combine(F); }
#undef IN
#undef SEAM
}

extern "C" void kernel_launch(void* const* d_in, const int* in_sizes, int n_in, void* d_out, int out_size, void* d_ws, size_t ws_size, hipStream_t stream) {
    static int grid = 0;
    if (grid == 0) {
        if (n_in != 26 || out_size != T_ * D_ || ws_size < WS_END) { fprintf(stderr, "kernel_launch: unexpected shapes (n_in %d, out %d, ws %zu)\n", n_in, out_size, ws_size); grid = -1; return; }
        int dev = 0, cus = 0, per_cu = 0;
        if (hipGetDevice(&dev) != hipSuccess || hipDeviceGetAttribute(&cus, hipDeviceAttributeMultiprocessorCount, dev) != hipSuccess) { grid = -1; return; }
        if (hipFuncSetAttribute((const void*)skel_fwd, hipFuncAttributeMaxDynamicSharedMemorySize, LDS_BYTES) != hipSuccess) { fprintf(stderr, "kernel_launch: hipFuncSetAttribute failed\n"); grid = -1; return; }
        if (hipOccupancyMaxActiveBlocksPerMultiprocessor(&per_cu, (const void*)skel_fwd, NWAVES * 64, LDS_BYTES) != hipSuccess || per_cu < 1) fprintf(stderr, "kernel_launch: occupancy query reports %d\n", per_cu);
        (void)hipGetLastError();
        grid = cus;
    }
    if (grid < 0) return;
    if (hipMemsetAsync((char*)d_ws + WS_CTL, 0, CTL_ZERO_BYTES, stream) != hipSuccess) return;
    Args a{};
    for (int i = 0; i < 26; ++i) a.in[i] = (const float*)d_in[i];
    a.out = (float*)d_out; a.ws = (unsigned char*)d_ws;
    if (MK_ONE_LAUNCH) { a.ph_lo = 0; a.ph_hi = N_PHASES; hipLaunchKernelGGL(skel_fwd, dim3(grid), dim3(NWAVES * 64), LDS_BYTES, stream, a); }
    else for (int p = 0; p < N_PHASES; ++p) { a.ph_lo = p; a.ph_hi = p + 1; hipLaunchKernelGGL(skel_fwd, dim3(grid), dim3(NWAVES * 64), LDS_BYTES, stream, a); }
}
```
